# Optimizing an MI355X kernel written in HIP

```python
import jax, jax.numpy as jnp
from jax import lax
import numpy as np

D_MODEL = 1024
BATCH = 8
SEQ = 4096
DEPTH = 2

HEAD_DIM = 64
N_HEADS_FOX = 8
N_HEADS_MOBA = 8
MIX_WIDTH = (N_HEADS_FOX + N_HEADS_MOBA) * HEAD_DIM
FOX_QKV_W = 3 * N_HEADS_FOX * HEAD_DIM
MOBA_QKV_W = 3 * N_HEADS_MOBA * HEAD_DIM
EVEN_IN_W = FOX_QKV_W + N_HEADS_FOX + MOBA_QKV_W + MIX_WIDTH
Q_BLOCK = 128
MOBA_BLOCK = 256
MOBA_TOPK = 3
ROPE_THETA = 500000.0
ROT_DIM = HEAD_DIM // 4
CONV_WIDTH = 31
CONV_CH = D_MODEL
NORM_EPS = 1e-6
LN_EPS = 1e-5

kernel_name = "fox_moba_conformer_hybrid"


def rms_norm(x, g):
    xf = x.astype(jnp.float32)
    y = xf * lax.rsqrt(jnp.mean(xf * xf, axis=-1, keepdims=True) + NORM_EPS)
    return (y * g.astype(jnp.float32)).astype(x.dtype)


def layer_norm(x, g, b):
    xf = x.astype(jnp.float32)
    mu = jnp.mean(xf, axis=-1, keepdims=True)
    xc = xf - mu
    y = xc * lax.rsqrt(jnp.mean(xc * xc, axis=-1, keepdims=True) + LN_EPS)
    return (y * g.astype(jnp.float32) + b.astype(jnp.float32)).astype(x.dtype)


def partial_rope(x, pos):
    half = ROT_DIM // 2
    inv_freq = ROPE_THETA ** (-jnp.arange(half, dtype=jnp.float32) / half)
    ang = pos.astype(jnp.float32)[:, None] * inv_freq[None, :]
    cos = jnp.cos(ang)[None, :, None, :]
    sin = jnp.sin(ang)[None, :, None, :]
    xf = x[..., :ROT_DIM].astype(jnp.float32)
    x1, x2 = xf[..., :half], xf[..., half:]
    rot = jnp.concatenate([x1 * cos - x2 * sin, x2 * cos + x1 * sin], axis=-1).astype(x.dtype)
    return jnp.concatenate([rot, x[..., ROT_DIM:]], axis=-1)


def fox_attention(q, k, v, logf):
    B, H, S, D = q.shape
    nqb = S // Q_BLOCK
    scale = D ** -0.5
    c = jnp.cumsum(logf, axis=-1)
    q_blocks = q.reshape(B, H, nqb, Q_BLOCK, D).transpose(2, 0, 1, 3, 4)
    c_blocks = c.reshape(B, H, nqb, Q_BLOCK).transpose(2, 0, 1, 3)
    k_pos = jnp.arange(S)

    def one_block(args):
        qb, cb, blk = args
        q_pos = blk * Q_BLOCK + jnp.arange(Q_BLOCK)
        logits = jnp.einsum('bhqd,bhkd->bhqk', qb, k).astype(jnp.float32) * scale
        logits = logits + cb[..., None] - c[:, :, None, :]
        logits = jnp.where(k_pos[None, :] <= q_pos[:, None], logits, -jnp.inf)
        p = jax.nn.softmax(logits, axis=-1)
        return jnp.einsum('bhqk,bhkd->bhqd', p.astype(v.dtype), v)

    out = lax.map(one_block, (q_blocks, c_blocks, jnp.arange(nqb)))
    return out.transpose(1, 0, 3, 2, 4).reshape(B, S, H, D)


def moba_attention(q, k, v):
    B, H, S, D = q.shape
    nqb = S // Q_BLOCK
    nblk = -(-S // MOBA_BLOCK)
    s_pad = nblk * MOBA_BLOCK
    scale = D ** -0.5
    pad = ((0, 0), (0, 0), (0, s_pad - S), (0, 0))
    kb = jnp.pad(k, pad).reshape(B, H, nblk, MOBA_BLOCK, D)
    vb = jnp.pad(v, pad).reshape(B, H, nblk, MOBA_BLOCK, D)
    kmean = jnp.mean(kb.astype(jnp.float32), axis=3)
    ksel = min(MOBA_TOPK, nblk)
    h_idx = jnp.arange(H)[:, None, None]
    blk_ids = jnp.arange(nblk)
    in_blk = jnp.arange(MOBA_BLOCK)

    def one_chunk(n):
        b = n // nqb
        q0 = (n % nqb) * Q_BLOCK
        own = q0 // MOBA_BLOCK
        qc = lax.dynamic_slice(q, (b, 0, q0, 0), (1, H, Q_BLOCK, D))[0]
        kb_b = lax.dynamic_index_in_dim(kb, b, 0, keepdims=False)
        vb_b = lax.dynamic_index_in_dim(vb, b, 0, keepdims=False)
        km_b = lax.dynamic_index_in_dim(kmean, b, 0, keepdims=False)
        gate = jnp.einsum('hqd,hnd->hqn', qc.astype(jnp.float32), km_b)
        gate = jnp.where(blk_ids[None, None, :] < own, gate, -jnp.inf)
        _, idx = lax.top_k(gate, ksel)
        valid = idx < own
        kg = kb_b[h_idx, idx]
        vg = vb_b[h_idx, idx]
        lp = jnp.einsum('hqd,hqnld->hqnl', qc, kg).astype(jnp.float32) * scale
        lp = jnp.where(valid[..., None], lp, -jnp.inf).reshape(H, Q_BLOCK, ksel * MOBA_BLOCK)
        k_own = lax.dynamic_index_in_dim(kb_b, own, 1, keepdims=False)
        v_own = lax.dynamic_index_in_dim(vb_b, own, 1, keepdims=False)
        lo = jnp.einsum('hqd,hld->hql', qc, k_own).astype(jnp.float32) * scale
        q_pos = q0 + jnp.arange(Q_BLOCK)
        key_pos = own * MOBA_BLOCK + in_blk
        lo = jnp.where(key_pos[None, :] <= q_pos[:, None], lo, -jnp.inf)
        p = jax.nn.softmax(jnp.concatenate([lp, lo], axis=-1), axis=-1)
        pp = p[..., :ksel * MOBA_BLOCK].reshape(H, Q_BLOCK, ksel, MOBA_BLOCK).astype(v.dtype)
        po = p[..., ksel * MOBA_BLOCK:].astype(v.dtype)
        return (jnp.einsum('hqnl,hqnld->hqd', pp, vg)
                + jnp.einsum('hql,hld->hqd', po, v_own))

    out = lax.map(one_chunk, jnp.arange(B * nqb))
    return out.reshape(B, nqb, H, Q_BLOCK, D).transpose(0, 1, 3, 2, 4).reshape(B, S, H, D)


def fox_moba_layer(x, norm_g, w_in, b_f, qn_fox, kn_fox, qn_moba, kn_moba, w_out):
    B, S, _ = x.shape
    h = rms_norm(x, norm_g)
    proj = h @ w_in
    fox_qkv, f_logit, moba_qkv, gate = jnp.split(
        proj, [FOX_QKV_W, FOX_QKV_W + N_HEADS_FOX, FOX_QKV_W + N_HEADS_FOX + MOBA_QKV_W], axis=-1)
    fox_qkv = fox_qkv.reshape(B, S, 3, N_HEADS_FOX, HEAD_DIM)
    qa = rms_norm(fox_qkv[:, :, 0], qn_fox)
    ka = rms_norm(fox_qkv[:, :, 1], kn_fox)
    va = fox_qkv[:, :, 2]
    logf = jax.nn.log_sigmoid((f_logit + b_f).astype(jnp.float32))
    out_a = fox_attention(qa.transpose(0, 2, 1, 3), ka.transpose(0, 2, 1, 3),
                          va.transpose(0, 2, 1, 3), logf.transpose(0, 2, 1))
    pos = jnp.arange(S)
    moba_qkv = moba_qkv.reshape(B, S, 3, N_HEADS_MOBA, HEAD_DIM)
    qb = partial_rope(rms_norm(moba_qkv[:, :, 0], qn_moba), pos)
    kb = partial_rope(rms_norm(moba_qkv[:, :, 1], kn_moba), pos)
    vb = moba_qkv[:, :, 2]
    out_b = moba_attention(qb.transpose(0, 2, 1, 3), kb.transpose(0, 2, 1, 3),
                           vb.transpose(0, 2, 1, 3))
    mix = jnp.concatenate([out_a, out_b], axis=2).reshape(B, S, MIX_WIDTH)
    return x + (mix * jax.nn.silu(gate)) @ w_out


def conformer_conv_layer(x, norm_g, w_in, conv_w, conv_b, ln_g, ln_b, w_out):
    h = rms_norm(x, norm_g)
    val, glu_gate, z = jnp.split(h @ w_in, 3, axis=-1)
    u = val * jax.nn.sigmoid(glu_gate)
    u = lax.conv_general_dilated(
        u, conv_w, window_strides=(1,), padding=((CONV_WIDTH - 1, 0),),
        dimension_numbers=('NWC', 'WIO', 'NWC'), feature_group_count=CONV_CH) + conv_b
    u = jax.nn.silu(layer_norm(u, ln_g, ln_b)) * jax.nn.silu(z)
    return x + u @ w_out


def setup_inputs(seed: int = 0) -> dict:
    key = jax.random.key(seed)
    ks = jax.random.split(key, 16)
    f32 = jnp.float32
    nrm = lambda k, shape, s: jax.random.normal(k, shape, f32) * s
    return {
        "x": jax.random.normal(ks[0], (BATCH, SEQ, D_MODEL), f32),
        "l0_norm": 1.0 + nrm(ks[1], (D_MODEL,), 0.02),
        "l0_w_in": nrm(ks[2], (D_MODEL, EVEN_IN_W), D_MODEL ** -0.5),
        "l0_b_f": jnp.linspace(2.0, 7.0, N_HEADS_FOX, dtype=f32) + nrm(ks[3], (N_HEADS_FOX,), 0.1),
        "l0_qn_fox": 1.0 + nrm(ks[4], (HEAD_DIM,), 0.02),
        "l0_kn_fox": 1.0 + nrm(ks[5], (HEAD_DIM,), 0.02),
        "l0_qn_moba": 1.0 + nrm(ks[6], (HEAD_DIM,), 0.02),
        "l0_kn_moba": 1.0 + nrm(ks[7], (HEAD_DIM,), 0.02),
        "l0_w_out": nrm(ks[8], (MIX_WIDTH, D_MODEL), MIX_WIDTH ** -0.5),
        "l1_norm": 1.0 + nrm(ks[9], (D_MODEL,), 0.02),
        "l1_w_in": nrm(ks[10], (D_MODEL, 3 * CONV_CH), D_MODEL ** -0.5),
        "l1_conv_w": nrm(ks[11], (CONV_WIDTH, 1, CONV_CH), CONV_WIDTH ** -0.5),
        "l1_conv_b": nrm(ks[12], (CONV_CH,), 0.02),
        "l1_ln_g": 1.0 + nrm(ks[13], (CONV_CH,), 0.02),
        "l1_ln_b": nrm(ks[14], (CONV_CH,), 0.02),
        "l1_w_out": nrm(ks[15], (CONV_CH, D_MODEL), CONV_CH ** -0.5),
    }


def reference(x, l0_norm, l0_w_in, l0_b_f, l0_qn_fox, l0_kn_fox, l0_qn_moba, l0_kn_moba, l0_w_out,
              l1_norm, l1_w_in, l1_conv_w, l1_conv_b, l1_ln_g, l1_ln_b, l1_w_out):
    even_params = [(l0_norm, l0_w_in, l0_b_f, l0_qn_fox, l0_kn_fox, l0_qn_moba, l0_kn_moba, l0_w_out)]
    odd_params = [(l1_norm, l1_w_in, l1_conv_w, l1_conv_b, l1_ln_g, l1_ln_b, l1_w_out)]
    for layer in range(DEPTH):
        if layer % 2 == 0:
            x = fox_moba_layer(x, *even_params[layer // 2])
        else:
            x = conformer_conv_layer(x, *odd_params[layer // 2])
    return x
```

```cpp
#include <hip/hip_runtime.h>
#include <hip/hip_cooperative_groups.h>
#include <cstdio>
#include <cstdint>
namespace cg = cooperative_groups;
namespace pg8 {
#define PG8_LAS __attribute__((address_space(3)))
typedef unsigned short bf16_t;
typedef short bf16x8 __attribute__((ext_vector_type(8)));
typedef float f32x4 __attribute__((ext_vector_type(4)));
typedef unsigned u32x4 __attribute__((ext_vector_type(4)));
constexpr int BM = 256, BK = 64, HALF = 128, HTB = HALF * BK * 2  , STAGE_BYTES = 8 * HTB, NXCD = 8, WGM = 8;

__host__ __device__ __forceinline__ int lds_byte(int r, int c) { const int st = (r >> 4) * 2 + (c >> 5), rr = r & 15, cc = c & 31, ob = rr * 64 + cc * 2; return st * 1024 + (ob ^ (((ob >> 9) & 1) << 5)); }
__host__ __device__ __forceinline__ void stage_rc(int b, int& R, int& C) { const int st = b / 1024, sb = b % 1024, swz = sb ^ (((sb >> 9) & 1) << 5); R = (st >> 1) * 16 + swz / 64; C = (st & 1) * 32 + (swz % 64) / 2; }
__host__ __device__ __forceinline__ int perm32(int rho) { const int n = rho >> 4, i = rho & 15; return 8 * (i >> 2) + 4 * n + (i & 3); }

struct Unit { int pm, pn; };
struct Gemm { const bf16_t* A; const bf16_t* Bt; int M, N, K; };

struct StaticOrder {
    int nM, nN, nwg, G, c;
    __host__ __device__ void init(int M, int N, int G_, int c_) { nM = M / BM; nN = N / BM; nwg = nM * nN; G = G_; c = c_; }
    __host__ __device__ bool next(int i, Unit& u) const {
        const long L = (long)i * G + c; if (L >= nwg) return false;
        int wgid = (int)L; { const int q = nwg / NXCD, r = nwg % NXCD, xcd = wgid % NXCD, off = wgid / NXCD; wgid = (xcd < r ? xcd * (q + 1) : r * (q + 1) + (xcd - r) * q) + off; }
        const int nig = WGM * nN, gid = wgid / nig, fm = gid * WGM, gsz = (nM - fm) < WGM ? (nM - fm) : WGM;
        u.pm = fm + ((wgid % nig) % gsz); u.pn = (wgid % nig) / gsz; return true;
    }
    __device__ __forceinline__ void a_ready(const Unit&) const {}
    __device__ __forceinline__ void done(const Unit&) const {}
};

__device__ __forceinline__ unsigned cvt_pk_bf16(float lo, float hi) { unsigned r; asm volatile("v_cvt_pk_bf16_f32 %0, %1, %2" : "=v"(r) : "v"(lo), "v"(hi)); return r; }
typedef float f32x2 __attribute__((ext_vector_type(2)));

constexpr float C2F = 0.125f * 1.4426950408889634f;
__device__ __forceinline__ float silu_f(float v) { return v * __builtin_amdgcn_rcpf(1.f + __expf(-v)); }
__device__ __forceinline__ u32x4 pack8(const float* v) { u32x4 w; w.x = cvt_pk_bf16(v[0], v[1]); w.y = cvt_pk_bf16(v[2], v[3]); w.z = cvt_pk_bf16(v[4], v[5]); w.w = cvt_pk_bf16(v[6], v[7]); return w; }

struct Epi1 {
    static constexpr bool PERM = true, AFTER_DRAIN = false;
    const float* rstd; bf16_t* qkv; bf16_t* sg; const float* gains; const float* rope; float* kmp;
    __device__ __forceinline__ void operator()(const f32x4 (&acc)[2][2][4][2], const Unit& u, int wr, int wc, int fr, int fq) const {
        const int pn = u.pn; const int row0 = u.pm * BM + wr * 64 + fr;
        float rsv[8];
#pragma unroll
        for (int i = 0; i < 8; ++i) rsv[i] = rstd[row0 + (i >> 2) * HALF + (i & 3) * 16];
        if (pn >= 12) {
            const int col0 = (pn - 12) * 256 + wc * 32 + 8 * fq;
#pragma unroll
            for (int ai = 0; ai < 2; ++ai)
#pragma unroll
                for (int m = 0; m < 4; ++m) {
                    const int r = row0 + ai * HALF + m * 16; const float rs = rsv[ai * 4 + m]; bf16_t* rowp = sg + (size_t)r * 1024 + col0;
#pragma unroll
                    for (int bj = 0; bj < 2; ++bj) { float v[8];
#pragma unroll
                        for (int n = 0; n < 2; ++n)
#pragma unroll
                            for (int e = 0; e < 4; ++e) v[4 * n + e] = silu_f(acc[ai][bj][m][n][e] * rs);
                        *(u32x4*)(rowp + bj * HALF) = pack8(v); }
                }
        } else {
            const int s = pn >> 1, head = 4 * (pn & 1) + wc;
            const bool isnorm = (s != 2) && (s != 5), isq = (s == 0) || (s == 3), isrope = (s == 3) || (s == 4);
            const float* gain = gains + 64 * ((s == 0) ? 0 : (s == 1) ? 1 : (s == 3) ? 2 : 3);
            float gn[2][8];
#pragma unroll
            for (int bj = 0; bj < 2; ++bj)
#pragma unroll
                for (int i = 0; i < 8; ++i) gn[bj][i] = isnorm ? gain[32 * bj + 8 * fq + i] * (isq ? C2F : 1.f) : 1.f;
            bf16_t* dst = qkv + (size_t)s * ((size_t)16 << 20);
            float csum[2][8];
#pragma unroll
            for (int bj = 0; bj < 2; ++bj)
#pragma unroll
                for (int i = 0; i < 8; ++i) csum[bj][i] = 0.f;
#pragma unroll
            for (int ai = 0; ai < 2; ++ai)
#pragma unroll
                for (int m = 0; m < 4; ++m) {
                    const int r = row0 + ai * HALF + m * 16; const float rs = rsv[ai * 4 + m];
                    float v[2][8]; float ss = 0.f;
#pragma unroll
                    for (int bj = 0; bj < 2; ++bj)
#pragma unroll
                        for (int n = 0; n < 2; ++n)
#pragma unroll
                            for (int e = 0; e < 4; ++e) { const float t_ = acc[ai][bj][m][n][e] * rs; v[bj][4 * n + e] = t_; ss += t_ * t_; }
                    const int t = r & 4095, b = r >> 12;
                    if (isnorm) {
                        ss += __shfl_xor(ss, 16); ss += __shfl_xor(ss, 32);
                        const float inv = __builtin_amdgcn_rsqf(ss * (1.0f / 64.0f) + 1e-6f);
#pragma unroll
                        for (int bj = 0; bj < 2; ++bj)
#pragma unroll
                            for (int i = 0; i < 8; ++i) v[bj][i] *= inv * gn[bj][i];
                        if (isrope) {
                            const f32x4* rp = (const f32x4*)(rope + t * 16);
                            f32x4 cs[4];
#pragma unroll
                            for (int k = 0; k < 4; ++k) cs[k] = rp[k];
#pragma unroll
                            for (int i = 0; i < 8; ++i) {
                                const float partner = __shfl_xor(v[0][i], 16);
                                const float c = cs[i >> 1][(i & 1) * 2], sn = cs[i >> 1][(i & 1) * 2 + 1];
                                const float rot = (fq == 0) ? (v[0][i] * c - partner * sn) : (v[0][i] * c + partner * sn);
                                v[0][i] = (fq < 2) ? rot : v[0][i];
                            }
                        }
                    }
                    bf16_t* p = dst + ((size_t)((b * 8 + head) * 4096 + t)) * 64 + 8 * fq;
                    *(u32x4*)(p) = pack8(v[0]); *(u32x4*)(p + 32) = pack8(v[1]);
                    if (s == 4) {
#pragma unroll
                        for (int bj = 0; bj < 2; ++bj)
#pragma unroll
                            for (int i = 0; i < 8; ++i) csum[bj][i] += v[bj][i];
                    }
                }
            if (s == 4) {
#pragma unroll
                for (int bj = 0; bj < 2; ++bj)
#pragma unroll
                    for (int i = 0; i < 8; ++i) { float c = csum[bj][i]; c += __shfl_xor(c, 1); c += __shfl_xor(c, 2); c += __shfl_xor(c, 4); c += __shfl_xor(c, 8); csum[bj][i] = c; }
                if (fr == 0) {
                    float* kp = kmp + ((size_t)wr * 64 * 16 + (size_t)((u.pm >> 4) * 8 + head) * 16 + (u.pm & 15)) * 64 + 8 * fq;
                    *(f32x4*)(kp) = (f32x4){csum[0][0], csum[0][1], csum[0][2], csum[0][3]}; *(f32x4*)(kp + 4) = (f32x4){csum[0][4], csum[0][5], csum[0][6], csum[0][7]};
                    *(f32x4*)(kp + 32) = (f32x4){csum[1][0], csum[1][1], csum[1][2], csum[1][3]}; *(f32x4*)(kp + 36) = (f32x4){csum[1][4], csum[1][5], csum[1][6], csum[1][7]};
                }
            }
        }
    }
};

struct Epi2 {
    static constexpr bool PERM = true, AFTER_DRAIN = false;
    const float* x; float* x1; bf16_t* x1b; float* ssqp;
    __device__ __forceinline__ void operator()(const f32x4 (&acc)[2][2][4][2], const Unit& u, int wr, int wc, int fr, int fq) const {
        const int row0 = u.pm * BM + wr * 64 + fr; const int col0 = u.pn * BM + wc * 32 + 8 * fq;
        float ssr[8];
#pragma unroll
        for (int ai = 0; ai < 2; ++ai) {
            f32x4 xv[4][2][2];
#pragma unroll
            for (int m = 0; m < 4; ++m)
#pragma unroll
                for (int bj = 0; bj < 2; ++bj) { const size_t off = (size_t)(row0 + ai * HALF + m * 16) * 1024 + col0 + bj * HALF; xv[m][bj][0] = *(const f32x4*)(x + off); xv[m][bj][1] = *(const f32x4*)(x + off + 4); }
#pragma unroll
            for (int m = 0; m < 4; ++m) {
                const int r = row0 + ai * HALF + m * 16; float ss = 0.f;
#pragma unroll
                for (int bj = 0; bj < 2; ++bj) {
                    const size_t off = (size_t)r * 1024 + col0 + bj * HALF;
                    const f32x4 va = xv[m][bj][0] + acc[ai][bj][m][0], vb = xv[m][bj][1] + acc[ai][bj][m][1];
                    float v[8] = {va[0], va[1], va[2], va[3], vb[0], vb[1], vb[2], vb[3]};
#pragma unroll
                    for (int i = 0; i < 8; ++i) ss += v[i] * v[i];
                    *(u32x4*)(x1b + off) = pack8(v);
                }
                ss += __shfl_xor(ss, 16); ss += __shfl_xor(ss, 32);
                ssr[ai * 4 + m] = ss;
            }
        }
        if (fq == 0) {
#pragma unroll
            for (int ai = 0; ai < 2; ++ai)
#pragma unroll
                for (int m = 0; m < 4; ++m) ssqp[(size_t)(row0 + ai * HALF + m * 16) * 16 + u.pn * 4 + wc] = ssr[ai * 4 + m];
        }
    }
};

struct Epi3 {
    static constexpr bool PERM = true, AFTER_DRAIN = false;
    const float* ssqp; bf16_t* U; bf16_t* SZ;
    __device__ __forceinline__ void operator()(const f32x4 (&acc)[2][2][4][2], const Unit& u, int wr, int wc, int fr, int fq) const {
        const int pn = u.pn; const int row0 = u.pm * BM + wr * 64 + fr;
#pragma unroll
        for (int ai = 0; ai < 2; ++ai) {
            float rsv[4];
#pragma unroll
            for (int m = 0; m < 4; ++m) {
                const f32x4* sp = (const f32x4*)(ssqp + (size_t)(row0 + ai * HALF + m * 16) * 16);
                const f32x4 s0 = sp[0], s1 = sp[1], s2 = sp[2], s3 = sp[3];
                const f32x4 st = (s0 + s1) + (s2 + s3);
                rsv[m] = __builtin_amdgcn_rsqf(((st[0] + st[1]) + (st[2] + st[3])) * (1.0f / 1024.0f) + 1e-6f); }
#pragma unroll
            for (int m = 0; m < 4; ++m) {
                const int r = row0 + ai * HALF + m * 16;
                const float rs = rsv[m];
                if (pn < 8) {
                    float v[8];
#pragma unroll
                    for (int n = 0; n < 2; ++n)
#pragma unroll
                        for (int e = 0; e < 4; ++e) { const float val = acc[ai][0][m][n][e] * rs, g = acc[ai][1][m][n][e] * rs; v[4 * n + e] = val * __builtin_amdgcn_rcpf(1.f + __expf(-g)); }
                    *(u32x4*)(U + (size_t)r * 1024 + pn * 128 + wc * 32 + 8 * fq) = pack8(v);
                } else {
#pragma unroll
                    for (int bj = 0; bj < 2; ++bj) { float v[8];
#pragma unroll
                        for (int n = 0; n < 2; ++n)
#pragma unroll
                            for (int e = 0; e < 4; ++e) v[4 * n + e] = silu_f(acc[ai][bj][m][n][e] * rs);
                        *(u32x4*)(SZ + (size_t)r * 1024 + (pn - 8) * 256 + bj * HALF + wc * 32 + 8 * fq) = pack8(v); }
                }
            }
        }
    }
};

struct Epi4 {
    static constexpr bool PERM = true, AFTER_DRAIN = false;
    float* out; const bf16_t* x1b;
    __device__ __forceinline__ void operator()(const f32x4 (&acc)[2][2][4][2], const Unit& u, int wr, int wc, int fr, int fq) const {
        const int row0 = u.pm * BM + wr * 64 + fr; const int col0 = u.pn * BM + wc * 32 + 8 * fq;
#pragma unroll
        for (int ai = 0; ai < 2; ++ai) {
            u32x4 xw[4][2];
#pragma unroll
            for (int m = 0; m < 4; ++m)
#pragma unroll
                for (int bj = 0; bj < 2; ++bj) xw[m][bj] = *(const u32x4*)(x1b + (size_t)(row0 + ai * HALF + m * 16) * 1024 + col0 + bj * HALF);
#pragma unroll
            for (int m = 0; m < 4; ++m)
#pragma unroll
                for (int bj = 0; bj < 2; ++bj) {
                    float* p = out + (size_t)(row0 + ai * HALF + m * 16) * 1024 + col0 + bj * HALF; const u32x4 w = xw[m][bj];
                    const f32x4 xa = {__uint_as_float(w.x << 16), __uint_as_float(w.x & 0xffff0000u), __uint_as_float(w.y << 16), __uint_as_float(w.y & 0xffff0000u)};
                    const f32x4 xb = {__uint_as_float(w.z << 16), __uint_as_float(w.z & 0xffff0000u), __uint_as_float(w.w << 16), __uint_as_float(w.w & 0xffff0000u)};
                    *(f32x4*)(p) = xa + acc[ai][bj][m][0]; *(f32x4*)(p + 4) = xb + acc[ai][bj][m][1];
                }
        }
    }
};

template <class Epi, class Sched, bool ALIGN_EPI = false, bool SP2 = false>
__device__ __forceinline__ void gemm_phase(PG8_LAS unsigned char* lds, const Gemm g, const Sched& S, const Epi& E, int wave_s) {
    const int lane = __builtin_amdgcn_mbcnt_hi(~0u, __builtin_amdgcn_mbcnt_lo(~0u, 0u)), wid = wave_s, tid = wave_s * 64 + lane, wr = wid >> 2, wc = wid & 3, fr = lane & 15, fq = lane >> 4;
    const int K = g.K, nt = K / BK;
    unsigned voffA[2], voffB[2];
#pragma unroll
    for (int i = 0; i < 2; ++i) { int R, C; stage_rc(tid * 16 + i * 8192, R, C); const int Rb = Epi::PERM ? ((R & ~31) + perm32(R & 31)) : R;
        voffA[i] = (unsigned)(R * K + C) * 2u; voffB[i] = (unsigned)(Rb * K + C) * 2u; }
    const size_t kstep = (size_t)(BK * 2);
    const size_t hstep = (size_t)HALF * K * 2;
    const size_t tstep = 2 * hstep;
    const unsigned ldsw = (unsigned)wid * 1024u;
    const int aoff = lds_byte(wr * 64 + fr, fq * 8), boff = lds_byte(wc * 32 + fr, fq * 8);
#define PG8_SA(b, h) (((b) * 2 + (h)) * HTB)
#define PG8_SB(b, h) ((4 + (b) * 2 + (h)) * HTB)
#define PG8_STAGE(bufoff, gbase, voff) do { _Pragma("unroll") for (int _i = 0; _i < 2; ++_i) \
        __builtin_amdgcn_global_load_lds((const unsigned*)((const char*)(gbase) + (voff)[_i]), (PG8_LAS unsigned*)(lds + (bufoff) + ldsw + _i * 8192), 16, 0, 0); } while (0)
#define PG8_LDA(dst, b, h) do { _Pragma("unroll") for (int m = 0; m < 4; ++m) _Pragma("unroll") for (int k = 0; k < 2; ++k) dst[m][k] = *(const PG8_LAS bf16x8*)(lds + PG8_SA(b, h) + aoff + m * 2048 + k * 1024); } while (0)
#define PG8_LDB(dst, b, h) do { _Pragma("unroll") for (int n = 0; n < 2; ++n) _Pragma("unroll") for (int k = 0; k < 2; ++k) dst[n][k] = *(const PG8_LAS bf16x8*)(lds + PG8_SB(b, h) + boff + n * 2048 + k * 1024); } while (0)
#define PG8_MMA(ai, bj, At, Bt) do { __builtin_amdgcn_s_setprio(1); _Pragma("unroll") for (int m = 0; m < 4; ++m) _Pragma("unroll") for (int n = 0; n < 2; ++n) _Pragma("unroll") for (int k = 0; k < 2; ++k) \
        acc[ai][bj][m][n] = __builtin_amdgcn_mfma_f32_16x16x32_bf16(Bt[n][k], At[m][k], acc[ai][bj][m][n], 0, 0, 0); __builtin_amdgcn_s_setprio(0); } while (0)
#define PG8_WAIT_V(n) asm volatile("s_waitcnt vmcnt(" #n ")" ::: "memory")
#define PG8_WAIT_L(n) asm volatile("s_waitcnt lgkmcnt(" #n ")" ::: "memory")
#define PG8_BAR __builtin_amdgcn_s_barrier()
#define PG8_SCHED __builtin_amdgcn_sched_barrier(0)
    Unit cur, nxt; int ui = 0;
    if (!S.next(0, cur)) return;
    f32x4 acc[2][2][4][2];
#pragma unroll
    for (int a = 0; a < 2; ++a)
#pragma unroll
        for (int b = 0; b < 2; ++b)
#pragma unroll
            for (int m = 0; m < 4; ++m)
#pragma unroll
                for (int n = 0; n < 2; ++n) acc[a][b][m][n] = (f32x4){0.f, 0.f, 0.f, 0.f};
    bf16x8 At[4][2], B0[2][2], B1[2][2];
    const char* cA = (const char*)g.A + (size_t)cur.pm * tstep; const char* cB = (const char*)g.Bt + (size_t)cur.pn * tstep;
    S.a_ready(cur);
    if constexpr (SP2) {
        PG8_STAGE(PG8_SB(0, 0), cB, voffB); PG8_STAGE(PG8_SB(0, 1), cB + hstep, voffB); PG8_STAGE(PG8_SA(0, 0), cA, voffA); PG8_STAGE(PG8_SA(0, 1), cA + hstep, voffA);
        if (wr == 1) PG8_BAR;
        PG8_WAIT_V(2); PG8_BAR;
        PG8_STAGE(PG8_SB(1, 0), cB + kstep, voffB); PG8_STAGE(PG8_SA(1, 0), cA + kstep, voffA); PG8_STAGE(PG8_SB(1, 1), cB + hstep + kstep, voffB);
        PG8_WAIT_V(6); PG8_BAR;
    } else {
        PG8_STAGE(PG8_SB(0, 0), cB, voffB); PG8_STAGE(PG8_SA(0, 0), cA, voffA); PG8_STAGE(PG8_SB(0, 1), cB + hstep, voffB); PG8_STAGE(PG8_SA(0, 1), cA + hstep, voffA);
        if (wr == 1) PG8_BAR;
        PG8_WAIT_V(4); PG8_BAR;
        PG8_STAGE(PG8_SB(1, 0), cB + kstep, voffB); PG8_STAGE(PG8_SA(1, 0), cA + kstep, voffA); PG8_STAGE(PG8_SB(1, 1), cB + hstep + kstep, voffB);
        PG8_WAIT_V(6); PG8_BAR;
    }
    for (;;) {
        const bool has_next = S.next(ui + 1, nxt);
        const char* nA = has_next ? (const char*)g.A + (size_t)nxt.pm * tstep : cA; const char* nB = has_next ? (const char*)g.Bt + (size_t)nxt.pn * tstep : cB;
        for (int t = 0; t < nt; t += 2) {
            const bool last = (t == nt - 2);
            const char* a1 = cA + (size_t)(t + 1) * kstep;
            const char* a2 = last ? nA : cA + (size_t)(t + 2) * kstep; const char* b2 = last ? nB : cB + (size_t)(t + 2) * kstep;
            const char* a3 = a2 + kstep; const char* b3 = b2 + kstep;
            if (last && has_next) S.a_ready(nxt);
            if constexpr (SP2) {
            PG8_LDB(B0, 0, 0); PG8_LDB(B1, 0, 1); PG8_SCHED; PG8_LDA(At, 0, 0); PG8_STAGE(PG8_SA(1, 1), a1 + hstep, voffA);
            PG8_WAIT_V(8); PG8_WAIT_L(0); PG8_BAR; PG8_MMA(0, 0, At, B0); PG8_MMA(0, 1, At, B1); PG8_BAR; PG8_SCHED;
            PG8_LDA(At, 0, 1); PG8_STAGE(PG8_SB(0, 0), b2, voffB); PG8_STAGE(PG8_SB(0, 1), b2 + hstep, voffB); PG8_STAGE(PG8_SA(0, 0), a2, voffA);
            PG8_WAIT_V(8); PG8_WAIT_L(0); PG8_BAR; PG8_MMA(1, 0, At, B0); PG8_MMA(1, 1, At, B1); PG8_BAR; PG8_SCHED;
            PG8_LDB(B0, 1, 0); PG8_LDB(B1, 1, 1); PG8_SCHED; PG8_LDA(At, 1, 0); PG8_STAGE(PG8_SA(0, 1), a2 + hstep, voffA);
            PG8_WAIT_V(8); PG8_WAIT_L(0); PG8_BAR; PG8_MMA(0, 0, At, B0); PG8_MMA(0, 1, At, B1); PG8_BAR; PG8_SCHED;
            PG8_LDA(At, 1, 1); PG8_STAGE(PG8_SB(1, 0), b3, voffB); PG8_STAGE(PG8_SB(1, 1), b3 + hstep, voffB); PG8_STAGE(PG8_SA(1, 0), a3, voffA);
            PG8_WAIT_V(8); PG8_WAIT_L(0); PG8_BAR; PG8_MMA(1, 0, At, B0); PG8_MMA(1, 1, At, B1); PG8_BAR; PG8_SCHED;
            } else {
            PG8_LDB(B0, 0, 0); PG8_SCHED; PG8_LDA(At, 0, 0); PG8_STAGE(PG8_SA(1, 1), a1 + hstep, voffA);
            PG8_WAIT_L(8); PG8_BAR; PG8_WAIT_L(0); PG8_MMA(0, 0, At, B0); PG8_BAR; PG8_SCHED;
            PG8_LDB(B1, 0, 1); PG8_STAGE(PG8_SB(0, 0), b2, voffB);
            PG8_BAR; PG8_WAIT_L(0); PG8_MMA(0, 1, At, B1); PG8_BAR;
            PG8_LDA(At, 0, 1); PG8_STAGE(PG8_SA(0, 0), a2, voffA);
            PG8_BAR; PG8_WAIT_L(0); PG8_MMA(1, 0, At, B0); PG8_BAR; PG8_SCHED;
            PG8_STAGE(PG8_SB(0, 1), b2 + hstep, voffB);
            PG8_WAIT_V(6); PG8_BAR; PG8_MMA(1, 1, At, B1); PG8_BAR;
            PG8_LDB(B0, 1, 0); PG8_SCHED; PG8_LDA(At, 1, 0); PG8_STAGE(PG8_SA(0, 1), a2 + hstep, voffA);
            PG8_WAIT_L(8); PG8_BAR; PG8_WAIT_L(0); PG8_MMA(0, 0, At, B0); PG8_BAR; PG8_SCHED;
            PG8_LDB(B1, 1, 1); PG8_STAGE(PG8_SB(1, 0), b3, voffB);
            PG8_BAR; PG8_WAIT_L(0); PG8_MMA(0, 1, At, B1); PG8_BAR;
            PG8_LDA(At, 1, 1); PG8_STAGE(PG8_SA(1, 0), a3, voffA);
            PG8_BAR; PG8_WAIT_L(0); PG8_MMA(1, 0, At, B0); PG8_BAR; PG8_SCHED;
            PG8_STAGE(PG8_SB(1, 1), b3 + hstep, voffB);
            PG8_WAIT_V(6); PG8_BAR; PG8_MMA(1, 1, At, B1); PG8_BAR;
            }
        }
        if constexpr (ALIGN_EPI) { if (wr == 0) PG8_BAR; }
        if constexpr (!Epi::AFTER_DRAIN) { E(acc, cur, wr, wc, fr, fq); S.done(cur); }
        if (!has_next) break;
#pragma unroll
        for (int a = 0; a < 2; ++a)
#pragma unroll
            for (int b = 0; b < 2; ++b)
#pragma unroll
                for (int m = 0; m < 4; ++m)
#pragma unroll
                    for (int n = 0; n < 2; ++n) acc[a][b][m][n] = (f32x4){0.f, 0.f, 0.f, 0.f};
        cur = nxt; cA = nA; cB = nB; ++ui;
        if constexpr (ALIGN_EPI) { if (wr == 1) PG8_BAR; }
    }
    PG8_WAIT_V(0);
    if constexpr (!ALIGN_EPI) { if (wr == 0) PG8_BAR; }
    PG8_BAR;
    if constexpr (Epi::AFTER_DRAIN) { E.fused(acc, cur, wr, wc, fr, fq, lds, wid, lane); S.done(cur); }
#undef PG8_SA
#undef PG8_SB
#undef PG8_STAGE
#undef PG8_LDA
#undef PG8_LDB
#undef PG8_MMA
#undef PG8_WAIT_V
#undef PG8_WAIT_L
#undef PG8_BAR
#undef PG8_SCHED
}
}

#ifndef REP_G1
#define REP_G1 1
#endif
#ifndef REP_G2
#define REP_G2 1
#endif
#ifndef REP_G3
#define REP_G3 1
#endif
#ifndef ATT_VAR
#define ATT_VAR -1
#endif
#ifndef REP_ATTN
#define REP_ATTN 1
#endif
#ifndef REP_SMALL
#define REP_SMALL 1
#endif
constexpr int NB = 8, SEQ = 4096, DM = 1024, NH = 8, HD = 64, M_TOK = NB * SEQ;
constexpr int EVEN_W = 4104, FLOG_COL = 1536, MOBA_COL = 1544, GATE_COL = 3080;
constexpr int NWAVES = 8, NTHREADS = 512;
constexpr int LDS_BYTES = 147456;

constexpr size_t MiB = (size_t)1 << 20;
constexpr size_t WS_W0T = 0, WS_WO0T = 8 * MiB, WS_W1T = 10 * MiB, WS_WO1T = 16 * MiB;
constexpr size_t WS_RSTD0 = 18 * MiB, WS_LOGF = 19 * MiB, WS_CUM = 20 * MiB, WS_KMEAN = 21 * MiB, WS_GAINS = 21 * MiB + 256 * 1024, WS_ROPE = 21 * MiB + 512 * 1024, WS_SSQP = 22 * MiB, WS_BAR = 24 * MiB, WS_KMP = 25 * MiB, WS_KX = 26 * MiB, WS_T0 = 30 * MiB, WS_QCTR = WS_BAR + 16384;
constexpr size_t WS_XB = 32 * MiB;
constexpr size_t WS_QKV = 96 * MiB;
constexpr size_t WS_SG = 288 * MiB, WS_MIX = 352 * MiB, WS_END = 416 * MiB;
constexpr size_t WS_U = 96 * MiB, WS_SZ = 160 * MiB, WS_A2 = 224 * MiB;

#define LAS __attribute__((address_space(3)))
typedef unsigned short bf16;
typedef float f32x4 __attribute__((ext_vector_type(4)));
typedef float f32x2 __attribute__((ext_vector_type(2)));
typedef float f32x16 __attribute__((ext_vector_type(16)));
typedef short bf16x8 __attribute__((ext_vector_type(8)));
typedef short s16x4 __attribute__((ext_vector_type(4)));
typedef unsigned u32x4 __attribute__((ext_vector_type(4)));
typedef unsigned u32x2 __attribute__((ext_vector_type(2)));
typedef __bf16 bf16x2_t __attribute__((ext_vector_type(2)));

__device__ __forceinline__ unsigned cvtpk(float lo, float hi) { f32x2 v = {lo, hi}; bf16x2_t b = __builtin_convertvector(v, bf16x2_t); return __builtin_bit_cast(unsigned, b); }
__device__ __forceinline__ float bflo(unsigned w) { return __uint_as_float(w << 16); }
__device__ __forceinline__ float bfhi(unsigned w) { return __uint_as_float(w & 0xffff0000u); }
__device__ __forceinline__ float dpp_add(float v, const int ctrl_tag) {
    int r;
    if (ctrl_tag == 0) r = __builtin_amdgcn_update_dpp(0, __builtin_bit_cast(int, v), 0xB1, 0xf, 0xf, false);
    else if (ctrl_tag == 1) r = __builtin_amdgcn_update_dpp(0, __builtin_bit_cast(int, v), 0x4E, 0xf, 0xf, false);
    else if (ctrl_tag == 2) r = __builtin_amdgcn_update_dpp(0, __builtin_bit_cast(int, v), 0x141, 0xf, 0xf, false);
    else r = __builtin_amdgcn_update_dpp(0, __builtin_bit_cast(int, v), 0x140, 0xf, 0xf, false);
    return v + __builtin_bit_cast(float, r);
}
__device__ __forceinline__ float wave_sum(float v) {
    v = dpp_add(v, 0); v = dpp_add(v, 1); v = dpp_add(v, 2); v = dpp_add(v, 3);
    v += __shfl_xor(v, 16); v += __shfl_xor(v, 32);
    return v;
}
__device__ __forceinline__ int crow(int r, int hi) { return (r & 3) + 8 * (r >> 2) + 4 * hi; }

__device__ __forceinline__ int lane_id() { return (int)(__builtin_amdgcn_mbcnt_hi(~0u, __builtin_amdgcn_mbcnt_lo(~0u, 0u)) & 63u); }
#define XB_TMO      128
#define XB_XCNT(j)  (256  + 64 * (j))
#define XB_XSUB(j)  (1280 + 64 * (j))
#define XB_XGEN(j)  (2304 + 64 * (j))
#define XB_TOP      3328
#define XB_TOPGEN   3392
#define XCD_BAR_WORDS 3456
#define XB_SPIN_CAP (1u << 18)

__device__ __forceinline__ unsigned xb_ld(unsigned* p)              { return __hip_atomic_load(p, __ATOMIC_RELAXED, __HIP_MEMORY_SCOPE_AGENT); }
__device__ __forceinline__ unsigned xb_add(unsigned* p, unsigned v) { return __hip_atomic_fetch_add(p, v, __ATOMIC_RELAXED, __HIP_MEMORY_SCOPE_AGENT); }
__device__ __forceinline__ unsigned xb_xcc_id() { return (unsigned)__builtin_amdgcn_s_getreg((3 << 11) | 20) & 0xFu; }
#define XB_SPIN(cond, bar) do { unsigned _sp = 0; while (cond) { __builtin_amdgcn_s_sleep(1); \
    if ((++_sp & 255u) == 0u) { if (xb_ld(&(bar)[XB_TMO])) break; if (_sp > XB_SPIN_CAP) { atomicAdd(&(bar)[XB_TMO], 1u); break; } } } } while (0)

struct XcdBarrier {
    unsigned* bar; unsigned x; int wave;
    volatile LAS unsigned* st;
};

__device__ __forceinline__ XcdBarrier xcd_barrier_post(unsigned* bar, volatile LAS unsigned* st, int wave) {
    XcdBarrier b; b.bar = bar; b.x = xb_xcc_id(); b.st = st; b.wave = wave;
    if (wave == 0 && lane_id() == 0) (void)xb_add(&bar[XB_XCNT(b.x)], 1u);
    return b;
}
__device__ __forceinline__ void xcd_barrier_complete(unsigned* bar, unsigned x, unsigned& nloc, unsigned& nx) {
    const unsigned G = gridDim.x * gridDim.y * gridDim.z;
    unsigned sum, cnt, mine, sp = 0u;
    for (;;) {
        sum = 0u; cnt = 0u; mine = 0u;
#pragma unroll
        for (unsigned j = 0; j < 16; ++j) { const unsigned c = xb_ld(&bar[XB_XCNT(j)]); sum += c; cnt += (c > 0u) ? 1u : 0u; mine = (j == x) ? c : mine; }
        if (sum == G) break;
        __builtin_amdgcn_s_sleep(1);
        if ((++sp & 255u) == 0u) { if (xb_ld(&bar[XB_TMO])) break; if (sp > XB_SPIN_CAP) { atomicAdd(&bar[XB_TMO], 1u); break; } }
    }
    nloc = mine > 0u ? mine : 1u; nx = cnt > 0u ? cnt : 1u;
}

__device__ __forceinline__ void xcd_barrier(const XcdBarrier& b) {
    asm volatile("s_waitcnt vmcnt(0)" ::: "memory");
    __syncthreads();
    if (b.wave == 0 && lane_id() == 0) {
        unsigned* bar = b.bar;
        __builtin_amdgcn_s_waitcnt(0);
        unsigned nloc = b.st[0], nx = b.st[1];
        if (nloc == 0u) { xcd_barrier_complete(bar, b.x, nloc, nx); b.st[0] = nloc; b.st[1] = nx; }
        const unsigned old = xb_add(&bar[XB_XSUB(b.x)], 1u);
        const unsigned gen = old / nloc;
        if (old + 1u == (gen + 1u) * nloc) {
            __builtin_amdgcn_fence(__ATOMIC_RELEASE, "agent");
            asm volatile("s_waitcnt vmcnt(0)" ::: "memory");
            const unsigned og = xb_add(&bar[XB_TOP], 1u);
            const unsigned tg = og / nx;
            if (og + 1u == (tg + 1u) * nx) xb_add(&bar[XB_TOPGEN], 1u);
            else XB_SPIN(xb_ld(&bar[XB_TOPGEN]) == tg, bar);
            __builtin_amdgcn_fence(__ATOMIC_ACQUIRE, "agent");
            xb_add(&bar[XB_XGEN(b.x)], 1u);
            asm volatile("s_waitcnt vmcnt(0)" ::: "memory");
        } else {
            XB_SPIN(xb_ld(&bar[XB_XGEN(b.x)]) == gen, bar);
            __builtin_amdgcn_fence(__ATOMIC_ACQUIRE, "agent");
            asm volatile("s_waitcnt vmcnt(0)" ::: "memory");
        }
    }
    __syncthreads();
}

struct Args { const float* in[16]; float* out; unsigned char* ws; int ph_lo, ph_hi, coop, pad; };

__device__ __forceinline__ void transpose_item(const float* W, int K, int Nsrc, const float* kscale, bf16* WT, LAS float* scr, int k0, int n0, int src0, int lane) {
    float wv[32];
#pragma unroll
    for (int i = 0; i < 32; ++i) { const int kk = 2 * i + (lane >> 5); wv[i] = W[(size_t)(k0 + kk) * Nsrc + src0 + (lane & 31)]; }
#pragma unroll
    for (int i = 0; i < 32; ++i) { const int kk = 2 * i + (lane >> 5); float w = wv[i]; if (kscale) w *= kscale[k0 + kk]; scr[kk * 33 + (lane & 31)] = w; }
    asm volatile("s_waitcnt lgkmcnt(0)" ::: "memory");
    const int c = lane & 7;
#pragma unroll
    for (int j = 0; j < 4; ++j) { const int n = (lane >> 3) + 8 * j; const LAS float* s = scr + (8 * c) * 33 + n;
        u32x4 o; o.x = cvtpk(s[0 * 33], s[1 * 33]); o.y = cvtpk(s[2 * 33], s[3 * 33]); o.z = cvtpk(s[4 * 33], s[5 * 33]); o.w = cvtpk(s[6 * 33], s[7 * 33]);
        *(u32x4*)(WT + (size_t)(n0 + n) * K + k0 + 8 * c) = o; }
    asm volatile("s_waitcnt lgkmcnt(0)" ::: "memory");
}
__device__ __forceinline__ int src_col_l0(int np) {
    const int pn = np >> 8, cp = np & 255;
    if (pn >= 12) return GATE_COL + (np - 3072);
    const int s = pn >> 1, bj = cp >> 7, wc = (cp >> 5) & 3, j = cp & 31, head = 4 * (pn & 1) + wc, d = 32 * bj + j;
    const int base = (s < 3) ? s * 512 : MOBA_COL + (s - 3) * 512;
    return base + head * 64 + d;
}
__device__ __forceinline__ int src_col_l1(int np) {
    const int pn = np >> 8, cp = np & 255;
    if (pn >= 8) return 2048 + (np - 2048);
    return ((cp >> 7) ? 1024 : 0) + pn * 128 + (cp & 127);
}

__device__ __forceinline__ void phase_prologue(const Args& a, LAS unsigned char* lds, int wave_s) {
    const int lane = lane_id(), wave = wave_s, tid = wave_s * 64 + lane;
    const int G = gridDim.x, gw = blockIdx.x * NWAVES + wave, NGW = G * NWAVES;
    unsigned char* ws = a.ws;
    const float* x = a.in[0]; const float* l0_norm = a.in[1]; const float* l0_w_in = a.in[2]; const float* l0_b_f = a.in[3];
    const float* l0_w_out = a.in[8]; const float* l1_norm = a.in[9]; const float* l1_w_in = a.in[10]; const float* l1_w_out = a.in[15];
    if (blockIdx.x == 0 && tid < 256) { const int k = tid >> 6; const float* src = (k == 0) ? a.in[4] : (k == 1) ? a.in[5] : (k == 2) ? a.in[6] : a.in[7]; ((float*)(ws + WS_GAINS))[tid] = src[tid & 63]; }
    LAS float* wfl = (LAS float*)(lds + 73728);
    {   float wa[16], wb[16];
#pragma unroll
        for (int j = 0; j < 16; ++j) { const int i = tid + j * NTHREADS, k = i >> 3, h = i & 7; wa[j] = l0_w_in[(size_t)k * EVEN_W + FLOG_COL + h]; wb[j] = l0_norm[k]; }
#pragma unroll
        for (int j = 0; j < 16; ++j) wfl[tid + j * NTHREADS] = wa[j] * wb[j]; }
    LAS float* scr = (LAS float*)(lds + wave * 8448);
    constexpr int I0 = 16 * 128, I1 = 16 * 32, I2 = 16 * 96, I3 = 16 * 32;
    for (int it = gw; it < I0 + I1 + I2 + I3; it += NGW) {
        int r = it;
        if (r < I0) { const int kb = r / 128, nb = r % 128; transpose_item(l0_w_in, 1024, EVEN_W, l0_norm, (bf16*)(ws + WS_W0T), scr, 64 * kb, 32 * nb, src_col_l0(32 * nb), lane); continue; } r -= I0;
        if (r < I1) { const int kb = r / 32, nb = r % 32; transpose_item(l0_w_out, 1024, 1024, nullptr, (bf16*)(ws + WS_WO0T), scr, 64 * kb, 32 * nb, 32 * nb, lane); continue; } r -= I1;
        if (r < I2) { const int kb = r / 96, nb = r % 96; transpose_item(l1_w_in, 1024, 3072, l1_norm, (bf16*)(ws + WS_W1T), scr, 64 * kb, 32 * nb, src_col_l1(32 * nb), lane); continue; } r -= I2;
        { const int kb = r / 32, nb = r % 32; transpose_item(l1_w_out, 1024, 1024, nullptr, (bf16*)(ws + WS_WO1T), scr, 64 * kb, 32 * nb, 32 * nb, lane); }
    }
    { float* rope = (float*)(ws + WS_ROPE);
      for (int i = blockIdx.x * NTHREADS + tid; i < SEQ * 8; i += G * NTHREADS) {
          const int pos = i >> 3, k = i & 7;
          const float inv_freq = exp2f(-(float)k * (18.931568569324174f / 8.0f));
          const float ang = (float)pos * inv_freq;
          const double rev = (double)ang * 0.15915494309189535;
          const float fr = (float)(rev - floor(rev));
          rope[2 * i] = __builtin_amdgcn_cosf(fr); rope[2 * i + 1] = __builtin_amdgcn_sinf(fr);
      } }
    __syncthreads();
    float* rstd0 = (float*)(ws + WS_RSTD0); float* logf = (float*)(ws + WS_LOGF); bf16* xb = (bf16*)(ws + WS_XB);
    f32x4 nv[4];
    if (gw < M_TOK) { const f32x4* xr0 = (const f32x4*)(x + (size_t)gw * DM) + lane;
#pragma unroll
        for (int j = 0; j < 4; ++j) nv[j] = xr0[64 * j]; }
    for (int m = gw; m < M_TOK; m += NGW) {
        f32x4 v[4]; float s = 0.f;
#pragma unroll
        for (int j = 0; j < 4; ++j) v[j] = nv[j];
        if (m + NGW < M_TOK) { const f32x4* xr = (const f32x4*)(x + (size_t)(m + NGW) * DM) + lane;
#pragma unroll
            for (int j = 0; j < 4; ++j) nv[j] = xr[64 * j]; }
#pragma unroll
        for (int j = 0; j < 4; ++j) s += (v[j].x * v[j].x + v[j].y * v[j].y) + (v[j].z * v[j].z + v[j].w * v[j].w);
        const float rstd = 1.0f / sqrtf(wave_sum(s) * (1.0f / DM) + 1e-6f);
        u32x2* o8 = (u32x2*)(xb + (size_t)m * DM) + lane;
        float fl[8];
#pragma unroll
        for (int h = 0; h < 8; ++h) fl[h] = 0.f;
#pragma unroll
        for (int j = 0; j < 4; ++j) {
            u32x2 pk; pk.x = cvtpk(v[j].x, v[j].y); pk.y = cvtpk(v[j].z, v[j].w); o8[64 * j] = pk;
#pragma unroll
            for (int e = 0; e < 4; ++e) {
                const LAS f32x4* wp = (const LAS f32x4*)(wfl + (256 * j + 4 * lane + e) * 8);
                const f32x4 w0 = wp[0], w1 = wp[1]; const float xv = v[j][e];
                fl[0] += xv * w0.x; fl[1] += xv * w0.y; fl[2] += xv * w0.z; fl[3] += xv * w0.w;
                fl[4] += xv * w1.x; fl[5] += xv * w1.y; fl[6] += xv * w1.z; fl[7] += xv * w1.w;
            }
        }
        float mine = 0.f;
#pragma unroll
        for (int h = 0; h < 8; ++h) { const float t_ = wave_sum(fl[h]); if (lane == h) mine = t_; }
        if (lane == 0) rstd0[m] = rstd;
        if (lane < 8) {
            const float f = mine * rstd + l0_b_f[lane];
            const float ls = fminf(f, 0.f) - log1pf(__expf(-fabsf(f)));
            logf[((size_t)((m >> 12) * 8 + lane)) * SEQ + (m & 4095)] = ls;
        }
    }
}

__device__ __forceinline__ void cumsum_item(const float* logf, float* cum2, bf16* kx, int* t0tab, int seq, LAS unsigned char* lds, int wave_s) {
    const int lane = lane_id(), wave = wave_s, tid = wave_s * 64 + lane;
    const f32x4* p = (const f32x4*)(logf + (size_t)seq * SEQ + tid * 8);
    const f32x4 a = p[0], b = p[1];
    float v[8] = {a.x, a.y, a.z, a.w, b.x, b.y, b.z, b.w};
#pragma unroll
    for (int i = 1; i < 8; ++i) v[i] += v[i - 1];
    float sc = v[7];
#pragma unroll
    for (int o = 1; o < 64; o <<= 1) { const float y = __shfl_up(sc, o); if (lane >= o) sc += y; }
    LAS float* wt = (LAS float*)lds;
    __syncthreads();
    if (lane == 63) wt[wave] = sc;
    __syncthreads();
    float off = sc - v[7];
    for (int w = 0; w < wave; ++w) off += wt[w];
    constexpr float L2E = 1.4426950408889634f;
    f32x4 o0 = {(v[0] + off) * L2E, (v[1] + off) * L2E, (v[2] + off) * L2E, (v[3] + off) * L2E}, o1 = {(v[4] + off) * L2E, (v[5] + off) * L2E, (v[6] + off) * L2E, (v[7] + off) * L2E};
    {
        u32x4* kxp = (u32x4*)(kx + ((size_t)seq * SEQ + tid * 8) * 8);
#pragma unroll
        for (int i = 0; i < 8; ++i) { const float nc = -((v[i] + off) * L2E);
            const unsigned h = cvtpk(nc, 0.f) & 0xffffu; const float r1 = nc - __uint_as_float(h << 16);
            const unsigned m = cvtpk(r1, 0.f) & 0xffffu; const float r2 = r1 - __uint_as_float(m << 16);
            const unsigned l = cvtpk(r2, 0.f) & 0xffffu;
            kxp[i] = (u32x4){h | (m << 16), l | 0x3F800000u, 0x3F803F80u, 0u}; } }
    f32x4* q = (f32x4*)(cum2 + (size_t)seq * SEQ + tid * 8); q[0] = o0; q[1] = o1;
    {
        LAS float* cend = (LAS float*)lds + 64; LAS float* cqb = (LAS float*)lds + 128;
        if ((tid & 7) == 7) cend[tid >> 3] = o1[3];
        if ((tid & 31) == 0) cqb[tid >> 5] = o0[0];
        __syncthreads();
        if (tid < 16) { const float cq_ = cqb[tid]; int t = 0; while (t < 4 * tid && cq_ - cend[t] < -64.0f) ++t; t0tab[seq * 16 + tid] = t & ~1; }
    }
    __syncthreads();
}

__device__ __forceinline__ void kmean_phase(const bf16* KM, float* kmean, LAS unsigned char* lds, int wave_s) {
    const int tid = wave_s * 64 + lane_id(), row = tid >> 3, ch = tid & 7;
    LAS float* red = (LAS float*)lds;
    for (int item = blockIdx.x; item < 64 * 16; item += gridDim.x) {
        const bf16* kp = KM + ((size_t)(item >> 4) * SEQ + (item & 15) * 256) * 64;
        float acc[8];
#pragma unroll
        for (int j = 0; j < 8; ++j) acc[j] = 0.f;
#pragma unroll
        for (int i = 0; i < 4; ++i) { const u32x4 v = *(const u32x4*)(kp + (size_t)(row + 64 * i) * 64 + ch * 8);
            acc[0] += bflo(v.x); acc[1] += bfhi(v.x); acc[2] += bflo(v.y); acc[3] += bfhi(v.y); acc[4] += bflo(v.z); acc[5] += bfhi(v.z); acc[6] += bflo(v.w); acc[7] += bfhi(v.w); }
        *(LAS f32x4*)(red + row * 64 + ch * 8) = (f32x4){acc[0], acc[1], acc[2], acc[3]};
        *(LAS f32x4*)(red + row * 64 + ch * 8 + 4) = (f32x4){acc[4], acc[5], acc[6], acc[7]};
        __syncthreads();
        if (tid < 64) { float s = 0.f;
#pragma unroll 8
            for (int r = 0; r < 64; ++r) s += red[r * 64 + tid];
            kmean[(size_t)item * 64 + tid] = s * (1.0f / 256.0f); }
        __syncthreads();
    }
}

constexpr int AT_STG = 18688, AT_KPL = 1040, AT_VPL = 4160, AT_VOF = 8320, AT_KXO = 16640;
constexpr int AT_SEL = 3 * AT_STG, AT_KM = AT_SEL + 1024, AT_WL = AT_KM + 4096, AT_OST = AT_WL + 1024, AT_CK = AT_OST + 32768;
typedef short v4i16_t __attribute__((ext_vector_type(4)));
__device__ __forceinline__ s16x4 vtr(const LAS unsigned char* p) { return __builtin_bit_cast(s16x4, __builtin_amdgcn_ds_read_tr16_b64_v4i16((LAS v4i16_t*)p)); }

__device__ __forceinline__ void s_tile(f32x16& c0, f32x16& c1, const LAS unsigned char* Kb, const bf16x8 (&qr)[4]) {
#pragma unroll
    for (int d0 = 0; d0 < 4; ++d0) {
        const bf16x8 b0 = *(const LAS bf16x8*)(Kb + d0 * 2048), b1 = *(const LAS bf16x8*)(Kb + d0 * 2048 + 512);
        c0 = __builtin_amdgcn_mfma_f32_32x32x16_bf16(b0, qr[d0], c0, 0, 0, 0);
        c1 = __builtin_amdgcn_mfma_f32_32x32x16_bf16(b1, qr[d0], c1, 0, 0, 0);
    }
}
__device__ __forceinline__ void fox_init(f32x16& c0, f32x16& c1, const LAS float* ck, float cq2, int hi) {
#pragma unroll
    for (int g = 0; g < 4; ++g) { const f32x4 a = *(const LAS f32x4*)(ck + 8 * g + 4 * hi), bb = *(const LAS f32x4*)(ck + 32 + 8 * g + 4 * hi);
#pragma unroll
        for (int e = 0; e < 4; ++e) { c0[4 * g + e] = cq2 - a[e]; c1[4 * g + e] = cq2 - bb[e]; } }
}
__device__ __forceinline__ void causal_mask(f32x16& c0, f32x16& c1, int jb, int qrel, int hi) {
    const int kb = 64 * jb + 4 * hi;
#pragma unroll
    for (int r = 0; r < 16; ++r) { const int kv = kb + (r & 3) + 8 * (r >> 2); if (kv > qrel) c0[r] = -INFINITY; if (kv + 32 > qrel) c1[r] = -INFINITY; }
}
__device__ __forceinline__ float exp_tile(f32x16& c0, f32x16& c1, u32x4 (&pw)[4]) {
    float ps = 0.f;
#pragma unroll
    for (int r = 0; r < 16; ++r) { c0[r] = __builtin_amdgcn_exp2f(c0[r]); c1[r] = __builtin_amdgcn_exp2f(c1[r]); ps += c0[r] + c1[r]; }
#pragma unroll
    for (int s = 0; s < 2; ++s) {
        pw[s] = (u32x4){cvtpk(c0[8 * s], c0[8 * s + 1]), cvtpk(c0[8 * s + 2], c0[8 * s + 3]), cvtpk(c0[8 * s + 4], c0[8 * s + 5]), cvtpk(c0[8 * s + 6], c0[8 * s + 7])};
        pw[2 + s] = (u32x4){cvtpk(c1[8 * s], c1[8 * s + 1]), cvtpk(c1[8 * s + 2], c1[8 * s + 3]), cvtpk(c1[8 * s + 4], c1[8 * s + 5]), cvtpk(c1[8 * s + 6], c1[8 * s + 7])};
    }
    return ps;
}
__device__ __forceinline__ void pv_tile(f32x16& o0, f32x16& o1, const u32x4 (&pw)[4], const LAS unsigned char* vb) {
#pragma unroll
    for (int ks = 0; ks < 4; ++ks) {
        const bf16x8 pa = __builtin_bit_cast(bf16x8, pw[ks]);
        { const s16x4 lo = vtr(vb + ks * 1024), hh = vtr(vb + ks * 1024 + 512);
          const bf16x8 vf = {lo[0], lo[1], lo[2], lo[3], hh[0], hh[1], hh[2], hh[3]};
          o0 = __builtin_amdgcn_mfma_f32_32x32x16_bf16(pa, vf, o0, 0, 0, 0); }
        { const s16x4 lo = vtr(vb + 4096 + ks * 1024), hh = vtr(vb + 4096 + ks * 1024 + 512);
          const bf16x8 vf = {lo[0], lo[1], lo[2], lo[3], hh[0], hh[1], hh[2], hh[3]};
          o1 = __builtin_amdgcn_mfma_f32_32x32x16_bf16(pa, vf, o1, 0, 0, 0); }
    }
}

template <bool FOX, int VAR = 0>
__device__ __forceinline__ void attn_unit(LAS unsigned char* lds, int b, int h, int qb, const bf16* Q, const bf16* K, const bf16* V, const float* cum2, const float* kmean,
                                          const bf16* sg, bf16* mix, float ref2, int wave_s,
                                          bf16x8 (&qr)[4], u32x4& pk0, u32x4& pv0, u32x4& pk1, u32x4& pv1, int nbh, int nqb, int t0, int nt0) {
    int lane_o; asm volatile("v_mbcnt_lo_u32_b32 %0, -1, 0\n\tv_mbcnt_hi_u32_b32 %0, -1, %0" : "=v"(lane_o));
    const int lane = lane_o & 63, r32 = lane & 31, hi = lane >> 5, wid = wave_s, tid = wave_s * 64 + lane;
    const int bh = b * 8 + h;
    const bf16* Qh = Q + (size_t)bh * SEQ * 64; const bf16* Kh = K + (size_t)bh * SEQ * 64; const bf16* Vh = V + (size_t)bh * SEQ * 64;
    const int q0 = qb * 256 + wid * 32;
    const int NT = 4 * (qb + 1) - t0;
    float cqraw = 0.f; if (FOX) cqraw = cum2[(size_t)bh * SEQ + q0 + r32];
    f32x4 kma[4][2], kmb[4][2];
    if (!FOX) { const float* kmp0 = kmean + ((size_t)bh * 16 + r32) * 64 + hi * 8; const bool kvalid = (r32 < qb);
#pragma unroll
        for (int d0 = 0; d0 < 4; ++d0) { kma[d0][0] = kma[d0][1] = kmb[d0][0] = kmb[d0][1] = (f32x4){0.f, 0.f, 0.f, 0.f};
            if (kvalid) { kma[d0][0] = *(const f32x4*)(kmp0 + d0 * 16); kma[d0][1] = *(const f32x4*)(kmp0 + d0 * 16 + 4); kmb[d0][0] = *(const f32x4*)(kmp0 + 65536 + d0 * 16); kmb[d0][1] = *(const f32x4*)(kmp0 + 65536 + d0 * 16 + 4); } } }
    const int qrel4 = 32 * wid + r32 - 4 * hi;
    const int lrow = tid >> 3, lch = tid & 7;
    const bf16* kg = Kh + (size_t)t0 * 4096 + (size_t)lrow * 64 + lch * 8; const bf16* vg = Vh + (size_t)t0 * 4096 + (size_t)lrow * 64 + lch * 8;
    const int koff = lch * AT_KPL + lrow * 16, voff = AT_VOF + (lch >> 2) * AT_VPL + lrow * 64 + (lch & 3) * 16;
    const int vlane = AT_VOF + ((lane >> 4) & 1) * 32 + (lane & 3) * 8 + (4 * hi + ((lane & 15) >> 2)) * 64;
    const int klane = hi * AT_KPL + r32 * 16;
    const bf16* kxg = (const bf16*)((const unsigned char*)cum2 - WS_CUM + WS_KX) + ((size_t)bh * SEQ + (size_t)t0 * 64 + lane) * 8;
    u32x4 krw, vrw, kxw = {0u, 0u, 0u, 0u};
    if (FOX) { krw = *(const u32x4*)(kg + 2 * 4096); vrw = *(const u32x4*)(vg + 2 * 4096); if (wid == 0) kxw = *(const u32x4*)(kxg + 2 * 512); }
    {   const u32x4 k0 = pk0, v0 = pv0, k1 = pk1, v1 = pv1;
        if (FOX) { f32x4 c0_ = {0.f, 0.f, 0.f, 0.f}, c1_ = c0_; const int nck = 64 * (qb + 1);
            if (tid < nck) c0_ = *(const f32x4*)(cum2 + (size_t)bh * SEQ + tid * 4);
            if (tid + NTHREADS < nck) c1_ = *(const f32x4*)(cum2 + (size_t)bh * SEQ + (tid + NTHREADS) * 4);
            if (tid < nck) *(LAS f32x4*)(lds + AT_CK + tid * 16) = c0_;
            if (tid + NTHREADS < nck) *(LAS f32x4*)(lds + AT_CK + (tid + NTHREADS) * 16) = c1_; }
        *(LAS u32x4*)(lds + koff) = k0; *(LAS u32x4*)(lds + voff) = v0; *(LAS u32x4*)(lds + AT_STG + koff) = k1; *(LAS u32x4*)(lds + AT_STG + voff) = v1;
        if (FOX) { if (wid == 0) { const u32x4 x0 = *(const u32x4*)(kxg), x1 = *(const u32x4*)(kxg + 512); *(LAS u32x4*)(lds + AT_KXO + lane * 16) = x0; *(LAS u32x4*)(lds + AT_STG + AT_KXO + lane * 16) = x1; }
            if (tid >= 64 && tid < 256) *(LAS u32x4*)(lds + ((tid >> 6) - 1) * AT_STG + AT_KXO + 1024 + (tid & 63) * 16) = (u32x4){0u, 0u, 0u, 0u}; } }
    unsigned sel = 0u;
    if (!FOX) {
        const int own = qb;
        f32x16 gacc;
#pragma unroll
        for (int r = 0; r < 16; ++r) gacc[r] = 0.f;
#pragma unroll
        for (int d0 = 0; d0 < 4; ++d0) {
            const float km[8] = {(kma[d0][0].x + kmb[d0][0].x) * (1.0f / 256.0f), (kma[d0][0].y + kmb[d0][0].y) * (1.0f / 256.0f), (kma[d0][0].z + kmb[d0][0].z) * (1.0f / 256.0f), (kma[d0][0].w + kmb[d0][0].w) * (1.0f / 256.0f),
                                 (kma[d0][1].x + kmb[d0][1].x) * (1.0f / 256.0f), (kma[d0][1].y + kmb[d0][1].y) * (1.0f / 256.0f), (kma[d0][1].z + kmb[d0][1].z) * (1.0f / 256.0f), (kma[d0][1].w + kmb[d0][1].w) * (1.0f / 256.0f)};
            u32x4 hw, lw;
#pragma unroll
            for (int j = 0; j < 4; ++j) { const unsigned h_ = cvtpk(km[2 * j], km[2 * j + 1]); hw[j] = h_; lw[j] = cvtpk(km[2 * j] - bflo(h_), km[2 * j + 1] - bfhi(h_)); }
            gacc = __builtin_amdgcn_mfma_f32_32x32x16_bf16(__builtin_bit_cast(bf16x8, hw), qr[d0], gacc, 0, 0, 0);
            gacc = __builtin_amdgcn_mfma_f32_32x32x16_bf16(__builtin_bit_cast(bf16x8, lw), qr[d0], gacc, 0, 0, 0);
        }
        float g[16];
#pragma unroll
        for (int r = 0; r < 8; ++r) { const auto rr_ = __builtin_amdgcn_permlane32_swap(__float_as_uint(gacc[r]), __float_as_uint(gacc[r]), false, false);
            const int blk_ = (r & 3) + 8 * (r >> 2); g[blk_] = __uint_as_float(rr_[0]); g[blk_ + 4] = __uint_as_float(rr_[1]); }
#pragma unroll
        for (int n = 0; n < 15; ++n) g[n] = (n < own) ? g[n] : -INFINITY;
        unsigned mask = 0u;
#pragma unroll
        for (int n = 0; n < 15; ++n) {
            int rank = 0;
#pragma unroll
            for (int m = 0; m < 15; ++m) { if (m < n) rank += (g[m] >= g[n]) ? 1 : 0; else if (m > n) rank += (g[m] > g[n]) ? 1 : 0; }
            if (rank < 3) mask |= 1u << n;
        }
        sel = mask & ((1u << own) - 1u);
        krw = *(const u32x4*)(kg + 2 * 4096); vrw = *(const u32x4*)(vg + 2 * 4096);
    }
    __syncthreads();
    float cq2 = 0.f;
    bf16x8 qx = {0, 0, 0, 0, 0, 0, 0, 0};
    if (FOX) { cq2 = cqraw - ref2;
        const unsigned h_ = cvtpk(cq2, 0.f) & 0xffffu; const float r1_ = cq2 - __uint_as_float(h_ << 16);
        const unsigned m_ = cvtpk(r1_, 0.f) & 0xffffu; const float r2_ = r1_ - __uint_as_float(m_ << 16);
        const unsigned l_ = cvtpk(r2_, 0.f) & 0xffffu;
        const u32x4 w_ = (hi == 0) ? (u32x4){0x3F803F80u, 0x3F80u | (h_ << 16), m_ | (l_ << 16), 0u} : (u32x4){0u, 0u, 0u, 0u};
        qx = __builtin_bit_cast(bf16x8, w_); }
    f32x16 o0, o1;
#pragma unroll
    for (int r = 0; r < 16; ++r) { o0[r] = 0.f; o1[r] = 0.f; }
    float lsum = 0.f;
#define AT_INIT(N0, N1, TILE) do { const int tile_ = (TILE); \
        if (FOX) { const LAS float* ck_ = (const LAS float*)(lds + AT_CK) + (tile_ + t0) * 64; \
            _Pragma("unroll") for (int g_ = 0; g_ < 4; ++g_) { const f32x4 a_ = *(const LAS f32x4*)(ck_ + 8 * g_ + 4 * hi), b_ = *(const LAS f32x4*)(ck_ + 32 + 8 * g_ + 4 * hi); \
                _Pragma("unroll") for (int e_ = 0; e_ < 4; ++e_) { N0[4 * g_ + e_] = cq2 - a_[e_]; N1[4 * g_ + e_] = cq2 - b_[e_]; } } } \
        else { _Pragma("unroll") for (int r_ = 0; r_ < 16; ++r_) { N0[r_] = 0.f; N1[r_] = 0.f; } } \
        if (tile_ >= NT - 4) { int q4_ = qrel4; asm volatile("" : "+v"(q4_)); const float thr_ = (float)(q4_ - 64 * (tile_ - (NT - 4)));     \
            _Pragma("unroll") for (int r_ = 0; r_ < 16; ++r_) { const float c_ = (float)((r_ & 3) + 8 * (r_ >> 2)); N0[r_] = fminf(N0[r_], (thr_ - c_) * 1e30f); N1[r_] = fminf(N1[r_], (thr_ - (c_ + 32.0f)) * 1e30f); } } } while (0)
#define AT_KF(KFV, STAGE) do { const LAS unsigned char* kb_ = lds + (STAGE) + klane; \
        _Pragma("unroll") for (int d_ = 0; d_ < 4; ++d_) { KFV[2 * d_] = *(const LAS bf16x8*)(kb_ + d_ * 2 * AT_KPL); KFV[2 * d_ + 1] = *(const LAS bf16x8*)(kb_ + d_ * 2 * AT_KPL + 512); } } while (0)
#define AT_KFH(KFV, STAGE, H) do { int ka_ = (STAGE) + klane + (H) * 4 * AT_KPL; asm volatile("" : "+v"(ka_)); const LAS unsigned char* kb_ = lds + ka_; \
        _Pragma("unroll") for (int d_ = 0; d_ < 2; ++d_) { KFV[4 * (H) + 2 * d_] = *(const LAS bf16x8*)(kb_ + d_ * 2 * AT_KPL); KFV[4 * (H) + 2 * d_ + 1] = *(const LAS bf16x8*)(kb_ + d_ * 2 * AT_KPL + 512); } } while (0)
#define AT_EXP4(P, R0, W, J) do { P[R0] = __builtin_amdgcn_exp2f(P[R0]); P[R0 + 1] = __builtin_amdgcn_exp2f(P[R0 + 1]); P[R0 + 2] = __builtin_amdgcn_exp2f(P[R0 + 2]); P[R0 + 3] = __builtin_amdgcn_exp2f(P[R0 + 3]); \
        ps_ += (P[R0] + P[R0 + 1]) + (P[R0 + 2] + P[R0 + 3]); \
        if (FOX) { W[J] = cvtpk(P[R0], P[R0 + 1]); W[J + 1] = cvtpk(P[R0 + 2], P[R0 + 3]); } else { W[J] = cvtpk(P[R0], P[R0 + 1]) & rmu_; W[J + 1] = cvtpk(P[R0 + 2], P[R0 + 3]) & rmu_; } } while (0)
#define AT_VF(VLO, VHI, STAGE, D0) do { int va_ = (STAGE) + vlane + (D0) * AT_VPL; asm volatile("" : "+v"(va_)); const LAS unsigned char* vb_ = lds + va_; \
        _Pragma("unroll") for (int k_ = 0; k_ < 4; ++k_) { VLO[k_] = vtr(vb_ + k_ * 1024); VHI[k_] = vtr(vb_ + k_ * 1024 + 512); } } while (0)
#define AT_VFRAG(VLO, VHI, k) (bf16x8){VLO[k][0], VLO[k][1], VLO[k][2], VLO[k][3], VHI[k][0], VHI[k][1], VHI[k][2], VHI[k][3]}
#define SB() __builtin_amdgcn_sched_barrier(0)
    f32x16 xa0, xa1, xb0, xb1;
    {   bf16x8 kf[8]; AT_INIT(xa0, xa1, 0); AT_KF(kf, 0);
#pragma unroll
        for (int d0 = 0; d0 < 4; ++d0) { xa0 = __builtin_amdgcn_mfma_f32_32x32x16_bf16(kf[2 * d0], qr[d0], xa0, 0, 0, 0); xa1 = __builtin_amdgcn_mfma_f32_32x32x16_bf16(kf[2 * d0 + 1], qr[d0], xa1, 0, 0, 0); } }
    int s_cur = 0, s_nx1 = AT_STG, s_nx2 = 2 * AT_STG;
    u32x4 kra = krw, vra = vrw, kxa = kxw;
#define MFA(D, A, B) asm volatile("s_nop 1\n\tv_mfma_f32_32x32x16_bf16 %0, %1, %2, %0" : "+v"(D) : "v"(A), "v"(B))
#define MFN(D, A, B) asm volatile("v_mfma_f32_32x32x16_bf16 %0, %1, %2, %0" : "+v"(D) : "v"(A), "v"(B))
#define MFZ(D, A, B) asm volatile("v_mfma_f32_32x32x16_bf16 %0, %1, %2, 0" : "=&v"(D) : "v"(A), "v"(B))
#define AT_PINP(P, R0) asm volatile("" : "+v"(P[R0]), "+v"(P[R0 + 1]), "+v"(P[R0 + 2]), "+v"(P[R0 + 3]))
#define AT_PINW(W, J) asm volatile("" : "+v"(W[J]), "+v"(W[J + 1]))
#define AT_G(P, R0, W, J) do { AT_PINP(P, R0); AT_EXP4(P, R0, W, J); AT_PINW(W, J); } while (0)
#define AT_STEP(FAST, P0, P1, N0, N1, KL, VL, XL, KW, VW, XW, T) do { const int t_s = (T); \
        if (t_s + 3 < NT) { KL = *(const u32x4*)(kg + (size_t)(t_s + 3) * 4096); VL = *(const u32x4*)(vg + (size_t)(t_s + 3) * 4096); \
            if (FOX && wid == 0) XL = *(const u32x4*)(kxg + (size_t)(t_s + 3) * 512); } \
        bf16x8 kf[8], kx0, kx1; s16x4 vlo[4], vhi[4]; u32x4 pw[4]; float ps_ = 0.f; \
        const unsigned rmu_ = (FOX || t_s >= NT - 4 || ((sel >> (t_s >> 2)) & 1u)) ? 0xffffffffu : 0u; \
        if (!(FAST)) AT_INIT(N0, N1, t_s + 1); \
        AT_KFH(kf, s_nx1, 0); \
        if (FOX && (FAST)) { const LAS unsigned char* xb_ = lds + s_nx1 + AT_KXO + hi * 1024 + r32 * 16; kx0 = *(const LAS bf16x8*)(xb_); kx1 = *(const LAS bf16x8*)(xb_ + 512); } \
        SB(); \
        if (FOX && (FAST)) { MFZ(N0, kx0, qx); AT_G(P0, 0, pw[0], 0); MFZ(N1, kx1, qx); AT_G(P0, 4, pw[0], 2); MFN(N0, kf[0], qr[0]); AT_G(P0, 8, pw[1], 0); MFN(N1, kf[1], qr[0]); AT_G(P0, 12, pw[1], 2); } \
        else if (FAST) { MFZ(N0, kf[0], qr[0]); AT_G(P0, 0, pw[0], 0); MFZ(N1, kf[1], qr[0]); AT_G(P0, 4, pw[0], 2); } \
        else { MFA(N0, kf[0], qr[0]); AT_G(P0, 0, pw[0], 0); MFA(N1, kf[1], qr[0]); AT_G(P0, 4, pw[0], 2); } \
        AT_KFH(kf, s_nx1, 1); \
        MFN(N0, kf[2], qr[1]); if (!(FOX && (FAST))) AT_G(P0, 8, pw[1], 0); \
        MFN(N1, kf[3], qr[1]); if (!(FOX && (FAST))) AT_G(P0, 12, pw[1], 2); \
        AT_VF(vlo, vhi, s_cur, 0); \
        MFN(N0, kf[4], qr[2]); AT_G(P1, 0, pw[2], 0); \
        MFN(N1, kf[5], qr[2]); AT_G(P1, 4, pw[2], 2); \
        MFN(N0, kf[6], qr[3]); AT_G(P1, 8, pw[3], 0); \
        MFN(N1, kf[7], qr[3]); AT_G(P1, 12, pw[3], 2); \
        lsum += FOX ? ps_ : (rmu_ ? ps_ : 0.f); \
        {   s16x4 wlo[4], whi[4]; \
            _Pragma("unroll") for (int ks = 0; ks < 4; ++ks) { const bf16x8 pa_ = __builtin_bit_cast(bf16x8, pw[ks]); const bf16x8 vf_ = AT_VFRAG(vlo, vhi, ks); MFA(o0, pa_, vf_); if (ks == 1) { AT_VF(wlo, whi, s_cur, 1); } } \
            if (t_s + 2 < NT) { *(LAS u32x4*)(lds + s_nx2 + koff) = KW; *(LAS u32x4*)(lds + s_nx2 + voff) = VW; if (FOX && wid == 0) *(LAS u32x4*)(lds + s_nx2 + AT_KXO + lane * 16) = XW; } \
            _Pragma("unroll") for (int ks = 0; ks < 4; ++ks) { const bf16x8 pa_ = __builtin_bit_cast(bf16x8, pw[ks]); const bf16x8 vf_ = AT_VFRAG(wlo, whi, ks); MFA(o1, pa_, vf_); } } \
        asm volatile("s_waitcnt lgkmcnt(0)\n\ts_barrier" ::: "memory");     \
        { const int t_ = s_cur; s_cur = s_nx1; s_nx1 = s_nx2; s_nx2 = t_; } } while (0)
    {   const int npair = (NT - 2) / 2, nfast = (NT / 2 - 3 > 0) ? NT / 2 - 3 : 0;
#pragma unroll 1
        for (int tp = 0; tp < nfast; ++tp) {
            AT_STEP(1, xa0, xa1, xb0, xb1, kra, vra, kxa, krw, vrw, kxw, 2 * tp);
            AT_STEP(1, xb0, xb1, xa0, xa1, krw, vrw, kxw, kra, vra, kxa, 2 * tp + 1);
        }
#pragma unroll 1
        for (int tp = nfast; tp < npair; ++tp) {
            AT_STEP(0, xa0, xa1, xb0, xb1, kra, vra, kxa, krw, vrw, kxw, 2 * tp);
            AT_STEP(0, xb0, xb1, xa0, xa1, krw, vrw, kxw, kra, vra, kxa, 2 * tp + 1);
        }
        AT_STEP(0, xa0, xa1, xb0, xb1, kra, vra, kxa, krw, vrw, kxw, NT - 2);
    }
    asm volatile("s_nop 15\n\ts_nop 7" : "+v"(o0), "+v"(o1), "+v"(xb0), "+v"(xb1));
    int le; asm volatile("v_mbcnt_lo_u32_b32 %0, -1, 0\n\tv_mbcnt_hi_u32_b32 %0, -1, %0" : "=v"(le)); le &= 63;
    const int colbase = (FOX ? h : 8 + h) * 64;
    const int rowe = le >> 3, che = le & 7;
    const size_t gi0 = ((size_t)(b * SEQ + q0 + rowe)) * 1024 + colbase + che * 8;
    u32x4 gvv[4];
#pragma unroll
    for (int i = 0; i < 4; ++i) gvv[i] = *(const u32x4*)(sg + gi0 + (size_t)i * 8 * 1024);
    if (nbh >= 0) {
        const bf16* nQ = Q + (size_t)nbh * SEQ * 64 + (size_t)(nqb * 256 + wid * 32 + (le & 31)) * 64 + (le >> 5) * 8;
#pragma unroll
        for (int d0 = 0; d0 < 4; ++d0) qr[d0] = *(const bf16x8*)(nQ + d0 * 16);
        const size_t no = (size_t)nbh * SEQ * 64 + (size_t)nt0 * 4096 + (size_t)((wid * 64 + le) >> 3) * 64 + (le & 7) * 8;
        pk0 = *(const u32x4*)(K + no); pv0 = *(const u32x4*)(V + no); pk1 = *(const u32x4*)(K + no + 4096); pv1 = *(const u32x4*)(V + no + 4096);
    } else { pk0 = (u32x4){0u, 0u, 0u, 0u}; pv0 = pk0; pk1 = pk0; pv1 = pk0; }
    {
        u32x4 pw[4]; s16x4 vlo[4], vhi[4], wlo[4], whi[4]; float ps_ = 0.f; const unsigned rmu_ = 0xffffffffu;
        AT_VF(vlo, vhi, s_cur, 0); AT_VF(wlo, whi, s_cur, 1);
        AT_EXP4(xb0, 0, pw[0], 0); AT_EXP4(xb0, 4, pw[0], 2); AT_EXP4(xb0, 8, pw[1], 0); AT_EXP4(xb0, 12, pw[1], 2);
        AT_EXP4(xb1, 0, pw[2], 0); AT_EXP4(xb1, 4, pw[2], 2); AT_EXP4(xb1, 8, pw[3], 0); AT_EXP4(xb1, 12, pw[3], 2);
        lsum += ps_;
#pragma unroll
        for (int ks = 0; ks < 4; ++ks) { o0 = __builtin_amdgcn_mfma_f32_32x32x16_bf16(__builtin_bit_cast(bf16x8, pw[ks]), AT_VFRAG(vlo, vhi, ks), o0, 0, 0, 0);
            o1 = __builtin_amdgcn_mfma_f32_32x32x16_bf16(__builtin_bit_cast(bf16x8, pw[ks]), AT_VFRAG(wlo, whi, ks), o1, 0, 0, 0); }
    }
#undef AT_STEP
#undef AT_G
#undef MFA
#undef MFZ
#undef MFN
#undef AT_PINP
#undef AT_PINW
#undef AT_INIT
#undef AT_KF
#undef AT_EXP4
#undef AT_VF
#undef AT_VFRAG
#undef SB
    { auto rr_ = __builtin_amdgcn_permlane32_swap(__float_as_uint(lsum), __float_as_uint(lsum), false, false); lsum = __uint_as_float(rr_[0]) + __uint_as_float(rr_[1]); }
    {   const int r32e = le & 31, hie = le >> 5;
        LAS float* wl = (LAS float*)(lds + AT_WL) + wid * 32;
        if (hie == 0) wl[r32e] = lsum;
        LAS bf16* stg = (LAS bf16*)(lds + AT_OST) + wid * 2048;
        {   const LAS float* wlp = wl + 4 * hie; LAS bf16* sp = stg + (4 * hie) * 64 + r32e;
#pragma unroll
            for (int r = 0; r < 16; ++r) { const int oc = (r & 3) + 8 * (r >> 2); const float rl = __builtin_amdgcn_rcpf(wlp[oc]);
                sp[oc * 64] = (bf16)(cvtpk(o0[r] * rl, 0.f) & 0xffffu); sp[oc * 64 + 32] = (bf16)(cvtpk(o1[r] * rl, 0.f) & 0xffffu); } }
        const LAS bf16* sr = stg + rowe * 64 + che * 8;
#pragma unroll
        for (int i = 0; i < 4; ++i) {
            const u32x4 ov = *(const LAS u32x4*)(sr + i * 8 * 64);
            const size_t gi = gi0 + (size_t)i * 8 * 1024;
            const u32x4 gv = gvv[i];
            u32x4 res;
            res.x = cvtpk(bflo(ov.x) * bflo(gv.x), bfhi(ov.x) * bfhi(gv.x)); res.y = cvtpk(bflo(ov.y) * bflo(gv.y), bfhi(ov.y) * bfhi(gv.y));
            res.z = cvtpk(bflo(ov.z) * bflo(gv.z), bfhi(ov.z) * bfhi(gv.z)); res.w = cvtpk(bflo(ov.w) * bflo(gv.w), bfhi(ov.w) * bfhi(gv.w));
            *(u32x4*)(mix + gi) = res; } }
    __syncthreads();
}

__device__ __forceinline__ float gain_bound(const float* gq, const float* gk) {
    float mq = 0.f, mk = 0.f;
    for (int i = 0; i < 64; ++i) { mq = fmaxf(mq, fabsf(gq[i])); mk = fmaxf(mk, fabsf(gk[i])); }
    return 8.0f * mq * mk * 1.4426950408889634f * 1.02f + 0.25f;
}

#define AT_DECODE(I, BH, QB) do { const int w0_ = (I) & 255, w_ = ((w0_ & 7) << 5) | (w0_ >> 3), k_ = ((I) >> 8) & 3, sub_ = w_ & 3; BH = w_ >> 2; \
        QB = (k_ == 0) ? 15 - sub_ : (k_ == 1) ? 8 + sub_ : (k_ == 2) ? 7 - sub_ : sub_; } while (0)
#define AT_DECODEQ(I, BH, QB) do { const int j_ = (I) & 127; BH = (((I) >> 7) << 3) | ((j_ & 31) >> 2); QB = 4 * (3 - (j_ >> 5)) + 3 - (j_ & 3); } while (0)
#define AT_FETCH(QP, KP, VP, FBH, FQB, FT0) do { const int ln_ = lane_id(); \
            const bf16* fq_ = (QP) + (size_t)(FBH) * SEQ * 64 + (size_t)((FQB) * 256 + wave_s * 32 + (ln_ & 31)) * 64 + (ln_ >> 5) * 8; \
            _Pragma("unroll") for (int d0 = 0; d0 < 4; ++d0) qr[d0] = *(const bf16x8*)(fq_ + d0 * 16); \
            const size_t fo_ = (size_t)(FBH) * SEQ * 64 + (size_t)(FT0) * 4096 + (size_t)((wave_s * 64 + ln_) >> 3) * 64 + (ln_ & 7) * 8; \
            pk0 = *(const u32x4*)((KP) + fo_); pv0 = *(const u32x4*)((VP) + fo_); pk1 = *(const u32x4*)((KP) + fo_ + 4096); pv1 = *(const u32x4*)((VP) + fo_ + 4096); } while (0)
template <int VAR>
__device__ __forceinline__ void attn_phase(const Args& a, LAS unsigned char* lds, int wave_s, size_t mix_off) {
    unsigned char* ws = a.ws;
    const bf16* qkv = (const bf16*)(ws + WS_QKV); const size_t TS = (size_t)16 << 20;
    const float* cum2 = (const float*)(ws + WS_CUM); const float* kmean = (const float*)(ws + WS_KMP);
    const bf16* sg = (const bf16*)(ws + WS_SG); bf16* mix = (bf16*)(ws + mix_off);
    bf16x8 qr[4]; u32x4 pk0 = {0u, 0u, 0u, 0u}, pv0 = pk0, pk1 = pk0, pv1 = pk0;
#pragma unroll
    for (int d0 = 0; d0 < 4; ++d0) qr[d0] = (bf16x8){0, 0, 0, 0, 0, 0, 0, 0};
    {
        const float ref_f = gain_bound(a.in[4], a.in[5]);
        const int* t0tab = (const int*)(ws + WS_T0);
        const int w0 = (int)blockIdx.x & 255, vw = ((w0 & 7) << 5) | (w0 >> 3), bb = vw >> 5, team = (vw >> 4) & 1, sl = vw & 15, s4 = sl & 3, rot = sl >> 2;
        LAS int* hc = (LAS int*)(lds + 132096 + 64);
        const int tid_ = wave_s * 64 + lane_id();
        if (tid_ < 128) hc[tid_] = 4 * ((tid_ & 15) + 1) - t0tab[(bb * 8 + (tid_ >> 4)) * 16 + (tid_ & 15)];
        __syncthreads();
        if (tid_ < 8) { int c = 0; for (int i = 0; i < 16; ++i) c += hc[tid_ * 16 + i]; hc[128 + tid_] = c; }
        __syncthreads();
        int hsel[4];
        {   int cst[8];
#pragma unroll
            for (int h = 0; h < 8; ++h) cst[h] = __builtin_amdgcn_readfirstlane(hc[128 + h]);
#pragma unroll
            for (int i = 0; i < 4; ++i) hsel[i] = 0;
#pragma unroll
            for (int h = 0; h < 8; ++h) { int rk = 0;
#pragma unroll
                for (int g = 0; g < 8; ++g) rk += (cst[g] < cst[h] || (cst[g] == cst[h] && g < h)) ? 1 : 0;
                const int tm = (rk == 0 || rk == 3 || rk == 4 || rk == 7) ? 0 : 1;
                const int slt = (rk <= 1) ? 0 : (rk <= 3) ? 1 : (rk <= 5) ? 2 : 3;
                if (tm == team) { if (slt == 0) hsel[0] = h; else if (slt == 1) hsel[1] = h; else if (slt == 2) hsel[2] = h; else hsel[3] = h; } } }
        __syncthreads();
#define AT_UNITK(K, BH, QB) do { const int k_ = (K); QB = (k_ == 0) ? 15 - s4 : (k_ == 1) ? 8 + s4 : (k_ == 2) ? 7 - s4 : s4; const int hi_ = (k_ + rot) & 3; \
            BH = bb * 8 + ((hi_ == 0) ? hsel[0] : (hi_ == 1) ? hsel[1] : (hi_ == 2) ? hsel[2] : hsel[3]); } while (0)
        if ((int)gridDim.x != 256) {
            if ((int)blockIdx.x < 1024) { int fbh, fqb; AT_DECODE((int)blockIdx.x, fbh, fqb); AT_FETCH(qkv, qkv + TS, qkv + 2 * TS, fbh, fqb, t0tab[fbh * 16 + fqb]); }
#pragma unroll 1
            for (int i = blockIdx.x; i < 1024; i += gridDim.x) {
                int bh, qb, nbh = -1, nqb = 0, nt0 = 0; AT_DECODE(i, bh, qb); const int t0 = t0tab[bh * 16 + qb];
                if (i + (int)gridDim.x < 1024) { AT_DECODE(i + (int)gridDim.x, nbh, nqb); nt0 = t0tab[nbh * 16 + nqb]; }
                attn_unit<true, VAR>(lds, bh >> 3, bh & 7, qb, qkv, qkv + TS, qkv + 2 * TS, cum2, kmean, sg, mix, ref_f, wave_s, qr, pk0, pv0, pk1, pv1, nbh, nqb, t0, nt0);
            }
        } else {
        { int fbh, fqb; AT_UNITK(0, fbh, fqb); const int ft0 = t0tab[fbh * 16 + fqb]; AT_FETCH(qkv, qkv + TS, qkv + 2 * TS, fbh, fqb, ft0); }
#pragma unroll 1
        for (int k = 0; k < 4; ++k) {
            int bh, qb, nbh = -1, nqb = 0, nt0 = 0; AT_UNITK(k, bh, qb); const int t0 = t0tab[bh * 16 + qb];
            if (k + 1 < 4) { AT_UNITK(k + 1, nbh, nqb); nt0 = t0tab[nbh * 16 + nqb]; }
            attn_unit<true, VAR>(lds, bh >> 3, bh & 7, qb, qkv, qkv + TS, qkv + 2 * TS, cum2, kmean, sg, mix, ref_f, wave_s, qr, pk0, pv0, pk1, pv1, nbh, nqb, t0, nt0);
        } }
#undef AT_UNITK
    }
    {   const float ref_m = gain_bound(a.in[6], a.in[7]);
        if ((int)blockIdx.x < 1024) { int fbh, fqb; AT_DECODE((int)blockIdx.x, fbh, fqb); AT_FETCH(qkv + 3 * TS, qkv + 4 * TS, qkv + 5 * TS, fbh, fqb, 0); }
#pragma unroll 1
        for (int i = blockIdx.x; i < 1024; i += gridDim.x) {
            int bh, qb, nbh = -1, nqb = 0; AT_DECODE(i, bh, qb); if (i + (int)gridDim.x < 1024) AT_DECODE(i + (int)gridDim.x, nbh, nqb);
            attn_unit<false, VAR>(lds, bh >> 3, bh & 7, qb, qkv + 3 * TS, qkv + 4 * TS, qkv + 5 * TS, cum2, kmean, sg, mix, ref_m, wave_s, qr, pk0, pv0, pk1, pv1, nbh, nqb, 0, 0);
        } }
}

__device__ __forceinline__ void conv_phase(const Args& a, LAS unsigned char* lds, int wave_s) {
    const int lane = lane_id(), wid = wave_s, tid = wave_s * 64 + lane;
    unsigned char* ws = a.ws;
    const bf16* U = (const bf16*)(ws + WS_U); const bf16* SZ = (const bf16*)(ws + WS_SZ); bf16* A2 = (bf16*)(ws + WS_A2);
    const float* cw = a.in[11]; const float* cb = a.in[12]; const float* lg = a.in[13]; const float* lb = a.in[14];
    const int c0 = 2 * tid;
    float w0[31], w1[31];
#pragma unroll
    for (int j = 0; j < 31; ++j) { const f32x2 wv = *(const f32x2*)(cw + j * 1024 + c0); w0[j] = wv.x; w1[j] = wv.y; }
    const f32x2 bias = *(const f32x2*)(cb + c0), gam = *(const f32x2*)(lg + c0), bet = *(const f32x2*)(lb + c0);
    LAS float* red = (LAS float*)(lds + 62 * 2048);
    u32x4 pre[4];
#define CV_LOAD1(DST, ITEM, K) do { const int m0_ = (ITEM) * 32, t0_ = m0_ & 4095; const int idx_ = tid + (K) * NTHREADS, rr_ = idx_ >> 7, ch_ = idx_ & 127; DST = (u32x4){0u, 0u, 0u, 0u}; \
        if (idx_ < 62 * 128 && t0_ - 30 + rr_ >= 0) DST = *(const u32x4*)(U + (size_t)(m0_ - 30 + rr_) * 1024 + ch_ * 8); } while (0)
    const int vcu = ((int)gridDim.x % 8 == 0) ? ((int)blockIdx.x % 8) * ((int)gridDim.x / 8) + (int)blockIdx.x / 8 : (int)blockIdx.x;
    if (vcu < M_TOK / 32) {
#pragma unroll
        for (int k = 0; k < 4; ++k) CV_LOAD1(pre[k], vcu, k); }
    for (int item = vcu; item < M_TOK / 32; item += gridDim.x) {
        const int m0 = item * 32;
        {   u32x4 late[12];
#pragma unroll
            for (int k = 0; k < 12; ++k) CV_LOAD1(late[k], item, 4 + k);
#pragma unroll
            for (int k = 0; k < 4; ++k) { const int idx = tid + k * NTHREADS, rr = idx >> 7, ch = idx & 127; *(LAS u32x4*)(lds + rr * 2048 + ch * 16) = pre[k]; }
#pragma unroll
            for (int k = 4; k < 16; ++k) { const int idx = tid + k * NTHREADS, rr = idx >> 7, ch = idx & 127; if (idx < 62 * 128) *(LAS u32x4*)(lds + rr * 2048 + ch * 16) = late[k - 4]; } }
        __syncthreads();
        if (item + (int)gridDim.x < M_TOK / 32) {
#pragma unroll
            for (int k = 0; k < 4; ++k) CV_LOAD1(pre[k], item + (int)gridDim.x, k); }
#pragma unroll 1
        for (int half = 0; half < 2; ++half) {
            const LAS unsigned char* ub = lds + half * 16 * 2048 + tid * 4;
            float y0[16], y1[16];
#pragma unroll
            for (int k = 0; k < 16; ++k) { y0[k] = bias.x; y1[k] = bias.y; }
#pragma unroll
            for (int rr = 0; rr < 46; ++rr) {
                const unsigned uu = *(const LAS unsigned*)(ub + rr * 2048);
                const float ua = bflo(uu), ub_ = bfhi(uu);
#pragma unroll
                for (int tok = 0; tok < 16; ++tok) { if (rr - tok >= 0 && rr - tok <= 30) { y0[tok] += w0[rr - tok] * ua; y1[tok] += w1[rr - tok] * ub_; } }
            }
            unsigned zz[16];
#pragma unroll
            for (int tok = 0; tok < 16; ++tok) zz[tok] = *(const unsigned*)(SZ + (size_t)(m0 + half * 16 + tok) * 1024 + c0);
            float k1 = 0.f, k2 = 0.f;
#pragma unroll
            for (int tok = 0; tok < 16; ++tok) { const float s1 = wave_sum(y0[tok] + y1[tok]), s2 = wave_sum(y0[tok] * y0[tok] + y1[tok] * y1[tok]); if (lane == tok) { k1 = s1; k2 = s2; } }
            if (lane < 16) { red[wid * 16 + lane] = k1; red[128 + wid * 16 + lane] = k2; }
            __syncthreads();
            if (tid < 16) { float s1 = 0.f, s2 = 0.f;
#pragma unroll
                for (int w = 0; w < 8; ++w) { s1 += red[w * 16 + tid]; s2 += red[128 + w * 16 + tid]; }
                const float mean = s1 * (1.0f / 1024.0f); const float var = fmaxf(s2 * (1.0f / 1024.0f) - mean * mean, 0.f);
                red[256 + tid] = mean; red[272 + tid] = 1.0f / sqrtf(var + 1e-5f); }
            __syncthreads();
#pragma unroll
            for (int tok = 0; tok < 16; ++tok) {
                const float mean = red[256 + tok], rstd = red[272 + tok];
                float v0 = (y0[tok] - mean) * rstd * gam.x + bet.x, v1 = (y1[tok] - mean) * rstd * gam.y + bet.y;
                v0 = v0 * __builtin_amdgcn_rcpf(1.f + __expf(-v0)); v1 = v1 * __builtin_amdgcn_rcpf(1.f + __expf(-v1));
                const size_t gi = (size_t)(m0 + half * 16 + tok) * 1024 + c0;
                const unsigned z = zz[tok];
                *(unsigned*)(A2 + gi) = cvtpk(v0 * bflo(z), v1 * bfhi(z));
            }
            __syncthreads();
        }
    }
}

__global__ void __launch_bounds__(NTHREADS, 2) fwd_megakernel(Args a) {
    extern __shared__ __attribute__((aligned(16))) unsigned char lds_raw[];
    LAS unsigned char* lds = (LAS unsigned char*)lds_raw;
    cg::grid_group grid = cg::this_grid();
    unsigned char* ws = a.ws;
    const int lo = a.ph_lo, hi = a.ph_hi;
    volatile LAS unsigned* misc = (volatile LAS unsigned*)(lds + 132096);
    const int wave_s = __builtin_amdgcn_readfirstlane((int)threadIdx.x >> 6);
    if (a.coop == 2) grid.sync();
    if (wave_s == 0 && lane_id() < 2) misc[lane_id()] = 0u;
    __syncthreads();
    XcdBarrier bar; bar.bar = (unsigned*)(ws + WS_BAR); bar.x = 0; bar.st = nullptr; bar.wave = wave_s;
    if (a.coop) bar = xcd_barrier_post((unsigned*)(ws + WS_BAR), misc, wave_s);
#ifndef PH_MASK
#define PH_MASK 0xff
#endif
#define IN(k) (((PH_MASK >> (k)) & 1) && lo <= (k) && (k) < hi)
#define SEAM(k) do { if (a.coop && IN(k) && IN((k) + 1)) xcd_barrier(bar); } while (0)
    if (IN(0)) { for (int rep_ = 0; rep_ < REP_SMALL; ++rep_) { phase_prologue(a, lds, wave_s); __syncthreads(); } }
    SEAM(0);
    if (IN(1)) {
        pg8::Gemm g{(const pg8::bf16_t*)(ws + WS_XB), (const pg8::bf16_t*)(ws + WS_W0T), M_TOK, 4096, 1024}; pg8::StaticOrder S; S.init(M_TOK, 4096, gridDim.x, (int)blockIdx.x);
        pg8::Epi1 E{(const float*)(ws + WS_RSTD0), (pg8::bf16_t*)(ws + WS_QKV), (pg8::bf16_t*)(ws + WS_SG), (const float*)(ws + WS_GAINS), (const float*)(ws + WS_ROPE), (float*)(ws + WS_KMP)};
        _Pragma("unroll 1") for (int rep_ = 0; rep_ < REP_G1; ++rep_) pg8::gemm_phase<pg8::Epi1, pg8::StaticOrder, true, true>(lds, g, S, E, wave_s);
        for (int seq = blockIdx.x; seq < 64; seq += gridDim.x) cumsum_item((const float*)(ws + WS_LOGF), (float*)(ws + WS_CUM), (bf16*)(ws + WS_KX), (int*)(ws + WS_T0), seq, lds, wave_s);
    }
    SEAM(1);
    if (IN(3)) { attn_phase<0>(a, lds, wave_s, WS_MIX);
#if ATT_VAR >= 0
        attn_phase<ATT_VAR>(a, lds, wave_s, WS_END);
#endif
    }
    SEAM(3);
    if (IN(4)) {
        pg8::Gemm g{(const pg8::bf16_t*)(ws + WS_MIX), (const pg8::bf16_t*)(ws + WS_WO0T), M_TOK, 1024, 1024}; pg8::StaticOrder S; S.init(M_TOK, 1024, gridDim.x, (int)blockIdx.x);
        pg8::Epi2 E{a.in[0], a.out, (pg8::bf16_t*)(ws + WS_XB), (float*)(ws + WS_SSQP)};
        _Pragma("unroll 1") for (int rep_ = 0; rep_ < REP_G2; ++rep_) pg8::gemm_phase<pg8::Epi2, pg8::StaticOrder, true, true>(lds, g, S, E, wave_s);
    }
    SEAM(4);
    if (IN(5)) {
        pg8::Gemm g{(const pg8::bf16_t*)(ws + WS_XB), (const pg8::bf16_t*)(ws + WS_W1T), M_TOK, 3072, 1024}; pg8::StaticOrder S; S.init(M_TOK, 3072, gridDim.x, (int)blockIdx.x);
        pg8::Epi3 E{(const float*)(ws + WS_SSQP), (pg8::bf16_t*)(ws + WS_U), (pg8::bf16_t*)(ws + WS_SZ)};
        _Pragma("unroll 1") for (int rep_ = 0; rep_ < REP_G3; ++rep_) pg8::gemm_phase<pg8::Epi3, pg8::StaticOrder, true, true>(lds, g, S, E, wave_s);
    }
    SEAM(5);
    if (IN(6)) { for (int rep_ = 0; rep_ < REP_SMALL; ++rep_) conv_phase(a, lds, wave_s); }
    SEAM(6);
    if (IN(7)) {
        pg8::Gemm g{(const pg8::bf16_t*)(ws + WS_A2), (const pg8::bf16_t*)(ws + WS_WO1T), M_TOK, 1024, 1024}; pg8::StaticOrder S; S.init(M_TOK, 1024, gridDim.x, (int)blockIdx.x);
        pg8::Epi4 E{a.out, (const pg8::bf16_t*)(ws + WS_XB)};
        pg8::gemm_phase<pg8::Epi4, pg8::StaticOrder, true, true>(lds, g, S, E, wave_s);
    }
#undef IN
#undef SEAM
}

#ifndef MK_PER_PHASE
#define MK_PER_PHASE 0
#endif
extern "C" void kernel_launch(void* const* d_in, const int* in_sizes, int n_in, void* d_out, int out_size, void* d_ws, size_t ws_size, hipStream_t stream) {
    static int grid = 0;
    if (grid == 0) {
        if (n_in != 16 || out_size != M_TOK * DM || ws_size < WS_END + 64 * MiB) { fprintf(stderr, "kernel_launch: unexpected shapes (n_in %d out %d ws %zu)\n", n_in, out_size, ws_size); grid = -1; return; }
        int dev = 0, cus = 0, per_cu = 0;
        hipGetDevice(&dev); hipDeviceGetAttribute(&cus, hipDeviceAttributeMultiprocessorCount, dev);
        if (hipFuncSetAttribute((const void*)fwd_megakernel, hipFuncAttributeMaxDynamicSharedMemorySize, LDS_BYTES) != hipSuccess) { fprintf(stderr, "kernel_launch: hipFuncSetAttribute failed\n"); grid = -1; return; }
        if (hipOccupancyMaxActiveBlocksPerMultiprocessor(&per_cu, (const void*)fwd_megakernel, NTHREADS, LDS_BYTES) != hipSuccess || per_cu < 1) { fprintf(stderr, "kernel_launch: occupancy query says %d\n", per_cu); per_cu = 1; }
        (void)hipGetLastError();
        grid = cus * per_cu;
    }
    if (grid < 0) return;
    if (hipMemsetAsync((char*)d_ws + WS_BAR, 0, 16384 + 512, stream) != hipSuccess) { fprintf(stderr, "kernel_launch: memset failed\n"); return; }
    Args a{};
    for (int i = 0; i < 16; ++i) a.in[i] = (const float*)d_in[i];
    a.out = (float*)d_out; a.ws = (unsigned char*)d_ws;
#if MK_PER_PHASE
    for (int p = 0; p < 8; ++p) { a.ph_lo = p; a.ph_hi = p + 1; a.coop = 0; hipLaunchKernelGGL(fwd_megakernel, dim3(grid), dim3(NTHREADS), LDS_BYTES, stream, a); }
#else
    a.ph_lo = 0; a.ph_hi = 8; a.coop = 1;
    void* args[] = {&a};
    hipError_t e = hipLaunchCooperativeKernel((const void*)fwd_megakernel, dim3(grid), dim3(NTHREADS), args, LDS_BYTES, stream);
    if (e != hipSuccess) fprintf(stderr, "cooperative launch failed: %s (grid %d)\n", hipGetErrorString(e), grid);
#endif
}
```

```cpp
#include <hip/hip_runtime.h>
#include <hip/hip_cooperative_groups.h>
#include <cstdio>
#include <cstdint>
namespace cg = cooperative_groups;
namespace pg8 {
#define PG8_LAS __attribute__((address_space(3)))
typedef unsigned short bf16_t;
typedef short bf16x8 __attribute__((ext_vector_type(8)));
typedef float f32x4 __attribute__((ext_vector_type(4)));
typedef unsigned u32x4 __attribute__((ext_vector_type(4)));
constexpr int BM = 256, BK = 64, HALF = 128, HTB = HALF * BK * 2  , STAGE_BYTES = 8 * HTB, NXCD = 8, WGM = 8;

__host__ __device__ __forceinline__ int lds_byte(int r, int c) { const int st = (r >> 4) * 2 + (c >> 5), rr = r & 15, cc = c & 31, ob = rr * 64 + cc * 2; return st * 1024 + (ob ^ (((ob >> 9) & 1) << 5)); }
__host__ __device__ __forceinline__ void stage_rc(int b, int& R, int& C) { const int st = b / 1024, sb = b % 1024, swz = sb ^ (((sb >> 9) & 1) << 5); R = (st >> 1) * 16 + swz / 64; C = (st & 1) * 32 + (swz % 64) / 2; }
__host__ __device__ __forceinline__ int perm32(int rho) { const int n = rho >> 4, i = rho & 15; return 8 * (i >> 2) + 4 * n + (i & 3); }

struct Unit { int pm, pn; };
struct Gemm { const bf16_t* A; const bf16_t* Bt; int M, N, K; };

struct StaticOrder {
    int nM, nN, nwg, G, c;
    __host__ __device__ void init(int M, int N, int G_, int c_) { nM = M / BM; nN = N / BM; nwg = nM * nN; G = G_; c = c_; }
    __host__ __device__ bool next(int i, Unit& u) const {
        const long L = (long)i * G + c; if (L >= nwg) return false;
        int wgid = (int)L; { const int q = nwg / NXCD, r = nwg % NXCD, xcd = wgid % NXCD, off = wgid / NXCD; wgid = (xcd < r ? xcd * (q + 1) : r * (q + 1) + (xcd - r) * q) + off; }
        const int nig = WGM * nN, gid = wgid / nig, fm = gid * WGM, gsz = (nM - fm) < WGM ? (nM - fm) : WGM;
        u.pm = fm + ((wgid % nig) % gsz); u.pn = (wgid % nig) / gsz; return true;
    }
    __device__ __forceinline__ void a_ready(const Unit&) const {}
    __device__ __forceinline__ void done(const Unit&) const {}
};

__device__ __forceinline__ unsigned cvt_pk_bf16(float lo, float hi) { unsigned r; asm volatile("v_cvt_pk_bf16_f32 %0, %1, %2" : "=v"(r) : "v"(lo), "v"(hi)); return r; }
typedef float f32x2 __attribute__((ext_vector_type(2)));

constexpr float C2F = 0.125f * 1.4426950408889634f;
__device__ __forceinline__ float silu_f(float v) { return v * __builtin_amdgcn_rcpf(1.f + __expf(-v)); }
__device__ __forceinline__ u32x4 pack8(const float* v) { u32x4 w; w.x = cvt_pk_bf16(v[0], v[1]); w.y = cvt_pk_bf16(v[2], v[3]); w.z = cvt_pk_bf16(v[4], v[5]); w.w = cvt_pk_bf16(v[6], v[7]); return w; }

struct Epi1 {
    static constexpr bool PERM = true, AFTER_DRAIN = false;
    const float* rstd; bf16_t* qkv; bf16_t* sg; const float* gains; const float* rope; float* kmp;
    __device__ __forceinline__ void operator()(const f32x4 (&acc)[2][2][4][2], const Unit& u, int wr, int wc, int fr, int fq) const {
        const int pn = u.pn; const int row0 = u.pm * BM + wr * 64 + fr;
        float rsv[8];
#pragma unroll
        for (int i = 0; i < 8; ++i) rsv[i] = rstd[row0 + (i >> 2) * HALF + (i & 3) * 16];
        if (pn >= 12) {
            const int col0 = (pn - 12) * 256 + wc * 32 + 8 * fq;
#pragma unroll
            for (int ai = 0; ai < 2; ++ai)
#pragma unroll
                for (int m = 0; m < 4; ++m) {
                    const int r = row0 + ai * HALF + m * 16; const float rs = rsv[ai * 4 + m]; bf16_t* rowp = sg + (size_t)r * 1024 + col0;
#pragma unroll
                    for (int bj = 0; bj < 2; ++bj) { float v[8];
#pragma unroll
                        for (int n = 0; n < 2; ++n)
#pragma unroll
                            for (int e = 0; e < 4; ++e) v[4 * n + e] = silu_f(acc[ai][bj][m][n][e] * rs);
                        *(u32x4*)(rowp + bj * HALF) = pack8(v); }
                }
        } else {
            const int s = pn >> 1, head = 4 * (pn & 1) + wc;
            const bool isnorm = (s != 2) && (s != 5), isq = (s == 0) || (s == 3), isrope = (s == 3) || (s == 4);
            const float* gain = gains + 64 * ((s == 0) ? 0 : (s == 1) ? 1 : (s == 3) ? 2 : 3);
            float gn[2][8];
#pragma unroll
            for (int bj = 0; bj < 2; ++bj)
#pragma unroll
                for (int i = 0; i < 8; ++i) gn[bj][i] = isnorm ? gain[32 * bj + 8 * fq + i] * (isq ? C2F : 1.f) : 1.f;
            bf16_t* dst = qkv + (size_t)s * ((size_t)16 << 20);
            float csum[2][8];
#pragma unroll
            for (int bj = 0; bj < 2; ++bj)
#pragma unroll
                for (int i = 0; i < 8; ++i) csum[bj][i] = 0.f;
#pragma unroll
            for (int ai = 0; ai < 2; ++ai)
#pragma unroll
                for (int m = 0; m < 4; ++m) {
                    const int r = row0 + ai * HALF + m * 16; const float rs = rsv[ai * 4 + m];
                    float v[2][8]; float ss = 0.f;
#pragma unroll
                    for (int bj = 0; bj < 2; ++bj)
#pragma unroll
                        for (int n = 0; n < 2; ++n)
#pragma unroll
                            for (int e = 0; e < 4; ++e) { const float t_ = acc[ai][bj][m][n][e] * rs; v[bj][4 * n + e] = t_; ss += t_ * t_; }
                    const int t = r & 4095, b = r >> 12;
                    if (isnorm) {
                        ss += __shfl_xor(ss, 16); ss += __shfl_xor(ss, 32);
                        const float inv = __builtin_amdgcn_rsqf(ss * (1.0f / 64.0f) + 1e-6f);
#pragma unroll
                        for (int bj = 0; bj < 2; ++bj)
#pragma unroll
                            for (int i = 0; i < 8; ++i) v[bj][i] *= inv * gn[bj][i];
                        if (isrope) {
                            const f32x4* rp = (const f32x4*)(rope + t * 16);
                            f32x4 cs[4];
#pragma unroll
                            for (int k = 0; k < 4; ++k) cs[k] = rp[k];
#pragma unroll
                            for (int i = 0; i < 8; ++i) {
                                const float partner = __shfl_xor(v[0][i], 16);
                                const float c = cs[i >> 1][(i & 1) * 2], sn = cs[i >> 1][(i & 1) * 2 + 1];
                                const float rot = (fq == 0) ? (v[0][i] * c - partner * sn) : (v[0][i] * c + partner * sn);
                                v[0][i] = (fq < 2) ? rot : v[0][i];
                            }
                        }
                    }
                    bf16_t* p = dst + ((size_t)((b * 8 + head) * 4096 + t)) * 64 + 8 * fq;
                    *(u32x4*)(p) = pack8(v[0]); *(u32x4*)(p + 32) = pack8(v[1]);
                    if (s == 4) {
#pragma unroll
                        for (int bj = 0; bj < 2; ++bj)
#pragma unroll
                            for (int i = 0; i < 8; ++i) csum[bj][i] += v[bj][i];
                    }
                }
            if (s == 4) {
#pragma unroll
                for (int bj = 0; bj < 2; ++bj)
#pragma unroll
                    for (int i = 0; i < 8; ++i) { float c = csum[bj][i]; c += __shfl_xor(c, 1); c += __shfl_xor(c, 2); c += __shfl_xor(c, 4); c += __shfl_xor(c, 8); csum[bj][i] = c; }
                if (fr == 0) {
                    float* kp = kmp + ((size_t)wr * 64 * 16 + (size_t)((u.pm >> 4) * 8 + head) * 16 + (u.pm & 15)) * 64 + 8 * fq;
                    *(f32x4*)(kp) = (f32x4){csum[0][0], csum[0][1], csum[0][2], csum[0][3]}; *(f32x4*)(kp + 4) = (f32x4){csum[0][4], csum[0][5], csum[0][6], csum[0][7]};
                    *(f32x4*)(kp + 32) = (f32x4){csum[1][0], csum[1][1], csum[1][2], csum[1][3]}; *(f32x4*)(kp + 36) = (f32x4){csum[1][4], csum[1][5], csum[1][6], csum[1][7]};
                }
            }
        }
    }
};

struct Epi2 {
    static constexpr bool PERM = true, AFTER_DRAIN = false;
    const float* x; float* x1; bf16_t* x1b; float* ssqp;
    __device__ __forceinline__ void operator()(const f32x4 (&acc)[2][2][4][2], const Unit& u, int wr, int wc, int fr, int fq) const {
        const int row0 = u.pm * BM + wr * 64 + fr; const int col0 = u.pn * BM + wc * 32 + 8 * fq;
        float ssr[8];
#pragma unroll
        for (int ai = 0; ai < 2; ++ai) {
            f32x4 xv[4][2][2];
#pragma unroll
            for (int m = 0; m < 4; ++m)
#pragma unroll
                for (int bj = 0; bj < 2; ++bj) { const size_t off = (size_t)(row0 + ai * HALF + m * 16) * 1024 + col0 + bj * HALF; xv[m][bj][0] = *(const f32x4*)(x + off); xv[m][bj][1] = *(const f32x4*)(x + off + 4); }
#pragma unroll
            for (int m = 0; m < 4; ++m) {
                const int r = row0 + ai * HALF + m * 16; float ss = 0.f;
#pragma unroll
                for (int bj = 0; bj < 2; ++bj) {
                    const size_t off = (size_t)r * 1024 + col0 + bj * HALF;
                    const f32x4 va = xv[m][bj][0] + acc[ai][bj][m][0], vb = xv[m][bj][1] + acc[ai][bj][m][1];
                    float v[8] = {va[0], va[1], va[2], va[3], vb[0], vb[1], vb[2], vb[3]};
#pragma unroll
                    for (int i = 0; i < 8; ++i) ss += v[i] * v[i];
                    *(u32x4*)(x1b + off) = pack8(v);
                }
                ss += __shfl_xor(ss, 16); ss += __shfl_xor(ss, 32);
                ssr[ai * 4 + m] = ss;
            }
        }
        if (fq == 0) {
#pragma unroll
            for (int ai = 0; ai < 2; ++ai)
#pragma unroll
                for (int m = 0; m < 4; ++m) ssqp[(size_t)(row0 + ai * HALF + m * 16) * 16 + u.pn * 4 + wc] = ssr[ai * 4 + m];
        }
    }
};

struct Epi3 {
    static constexpr bool PERM = true, AFTER_DRAIN = false;
    const float* ssqp; bf16_t* U; bf16_t* SZ;
    __device__ __forceinline__ void operator()(const f32x4 (&acc)[2][2][4][2], const Unit& u, int wr, int wc, int fr, int fq) const {
        const int pn = u.pn; const int row0 = u.pm * BM + wr * 64 + fr;
#pragma unroll
        for (int ai = 0; ai < 2; ++ai) {
            float rsv[4];
#pragma unroll
            for (int m = 0; m < 4; ++m) {
                const f32x4* sp = (const f32x4*)(ssqp + (size_t)(row0 + ai * HALF + m * 16) * 16);
                const f32x4 s0 = sp[0], s1 = sp[1], s2 = sp[2], s3 = sp[3];
                const f32x4 st = (s0 + s1) + (s2 + s3);
                rsv[m] = __builtin_amdgcn_rsqf(((st[0] + st[1]) + (st[2] + st[3])) * (1.0f / 1024.0f) + 1e-6f); }
#pragma unroll
            for (int m = 0; m < 4; ++m) {
                const int r = row0 + ai * HALF + m * 16;
                const float rs = rsv[m];
                if (pn < 8) {
                    float v[8];
#pragma unroll
                    for (int n = 0; n < 2; ++n)
#pragma unroll
                        for (int e = 0; e < 4; ++e) { const float val = acc[ai][0][m][n][e] * rs, g = acc[ai][1][m][n][e] * rs; v[4 * n + e] = val * __builtin_amdgcn_rcpf(1.f + __expf(-g)); }
                    *(u32x4*)(U + (size_t)r * 1024 + pn * 128 + wc * 32 + 8 * fq) = pack8(v);
                } else {
#pragma unroll
                    for (int bj = 0; bj < 2; ++bj) { float v[8];
#pragma unroll
                        for (int n = 0; n < 2; ++n)
#pragma unroll
                            for (int e = 0; e < 4; ++e) v[4 * n + e] = silu_f(acc[ai][bj][m][n][e] * rs);
                        *(u32x4*)(SZ + (size_t)r * 1024 + (pn - 8) * 256 + bj * HALF + wc * 32 + 8 * fq) = pack8(v); }
                }
            }
        }
    }
};

struct Epi4 {
    static constexpr bool PERM = true, AFTER_DRAIN = false;
    float* out; const bf16_t* x1b;
    __device__ __forceinline__ void operator()(const f32x4 (&acc)[2][2][4][2], const Unit& u, int wr, int wc, int fr, int fq) const {
        const int row0 = u.pm * BM + wr * 64 + fr; const int col0 = u.pn * BM + wc * 32 + 8 * fq;
#pragma unroll
        for (int ai = 0; ai < 2; ++ai) {
            u32x4 xw[4][2];
#pragma unroll
            for (int m = 0; m < 4; ++m)
#pragma unroll
                for (int bj = 0; bj < 2; ++bj) xw[m][bj] = *(const u32x4*)(x1b + (size_t)(row0 + ai * HALF + m * 16) * 1024 + col0 + bj * HALF);
#pragma unroll
            for (int m = 0; m < 4; ++m)
#pragma unroll
                for (int bj = 0; bj < 2; ++bj) {
                    float* p = out + (size_t)(row0 + ai * HALF + m * 16) * 1024 + col0 + bj * HALF; const u32x4 w = xw[m][bj];
                    const f32x4 xa = {__uint_as_float(w.x << 16), __uint_as_float(w.x & 0xffff0000u), __uint_as_float(w.y << 16), __uint_as_float(w.y & 0xffff0000u)};
                    const f32x4 xb = {__uint_as_float(w.z << 16), __uint_as_float(w.z & 0xffff0000u), __uint_as_float(w.w << 16), __uint_as_float(w.w & 0xffff0000u)};
                    *(f32x4*)(p) = xa + acc[ai][bj][m][0]; *(f32x4*)(p + 4) = xb + acc[ai][bj][m][1];
                }
        }
    }
};

template <class Epi, class Sched, bool ALIGN_EPI = false, bool SP2 = false>
__device__ __forceinline__ void gemm_phase(PG8_LAS unsigned char* lds, const Gemm g, const Sched& S, const Epi& E, int wave_s) {
    const int lane = __builtin_amdgcn_mbcnt_hi(~0u, __builtin_amdgcn_mbcnt_lo(~0u, 0u)), wid = wave_s, tid = wave_s * 64 + lane, wr = wid >> 2, wc = wid & 3, fr = lane & 15, fq = lane >> 4;
    const int K = g.K, nt = K / BK;
    unsigned voffA[2], voffB[2];
#pragma unroll
    for (int i = 0; i < 2; ++i) { int R, C; stage_rc(tid * 16 + i * 8192, R, C); const int Rb = Epi::PERM ? ((R & ~31) + perm32(R & 31)) : R;
        voffA[i] = (unsigned)(R * K + C) * 2u; voffB[i] = (unsigned)(Rb * K + C) * 2u; }
    const size_t kstep = (size_t)(BK * 2);
    const size_t hstep = (size_t)HALF * K * 2;
    const size_t tstep = 2 * hstep;
    const unsigned ldsw = (unsigned)wid * 1024u;
    const int aoff = lds_byte(wr * 64 + fr, fq * 8), boff = lds_byte(wc * 32 + fr, fq * 8);
#define PG8_SA(b, h) (((b) * 2 + (h)) * HTB)
#define PG8_SB(b, h) ((4 + (b) * 2 + (h)) * HTB)
#define PG8_STAGE(bufoff, gbase, voff) do { _Pragma("unroll") for (int _i = 0; _i < 2; ++_i) \
        __builtin_amdgcn_global_load_lds((const unsigned*)((const char*)(gbase) + (voff)[_i]), (PG8_LAS unsigned*)(lds + (bufoff) + ldsw + _i * 8192), 16, 0, 0); } while (0)
#define PG8_LDA(dst, b, h) do { _Pragma("unroll") for (int m = 0; m < 4; ++m) _Pragma("unroll") for (int k = 0; k < 2; ++k) dst[m][k] = *(const PG8_LAS bf16x8*)(lds + PG8_SA(b, h) + aoff + m * 2048 + k * 1024); } while (0)
#define PG8_LDB(dst, b, h) do { _Pragma("unroll") for (int n = 0; n < 2; ++n) _Pragma("unroll") for (int k = 0; k < 2; ++k) dst[n][k] = *(const PG8_LAS bf16x8*)(lds + PG8_SB(b, h) + boff + n * 2048 + k * 1024); } while (0)
#define PG8_MMA(ai, bj, At, Bt) do { __builtin_amdgcn_s_setprio(1); _Pragma("unroll") for (int m = 0; m < 4; ++m) _Pragma("unroll") for (int n = 0; n < 2; ++n) _Pragma("unroll") for (int k = 0; k < 2; ++k) \
        acc[ai][bj][m][n] = __builtin_amdgcn_mfma_f32_16x16x32_bf16(Bt[n][k], At[m][k], acc[ai][bj][m][n], 0, 0, 0); __builtin_amdgcn_s_setprio(0); } while (0)
#define PG8_WAIT_V(n) asm volatile("s_waitcnt vmcnt(" #n ")" ::: "memory")
#define PG8_WAIT_L(n) asm volatile("s_waitcnt lgkmcnt(" #n ")" ::: "memory")
#define PG8_BAR __builtin_amdgcn_s_barrier()
#define PG8_SCHED __builtin_amdgcn_sched_barrier(0)
    Unit cur, nxt; int ui = 0;
    if (!S.next(0, cur)) return;
    f32x4 acc[2][2][4][2];
#pragma unroll
    for (int a = 0; a < 2; ++a)
#pragma unroll
        for (int b = 0; b < 2; ++b)
#pragma unroll
            for (int m = 0; m < 4; ++m)
#pragma unroll
                for (int n = 0; n < 2; ++n) acc[a][b][m][n] = (f32x4){0.f, 0.f, 0.f, 0.f};
    bf16x8 At[4][2], B0[2][2], B1[2][2];
    const char* cA = (const char*)g.A + (size_t)cur.pm * tstep; const char* cB = (const char*)g.Bt + (size_t)cur.pn * tstep;
    S.a_ready(cur);
    if constexpr (SP2) {
        PG8_STAGE(PG8_SB(0, 0), cB, voffB); PG8_STAGE(PG8_SB(0, 1), cB + hstep, voffB); PG8_STAGE(PG8_SA(0, 0), cA, voffA); PG8_STAGE(PG8_SA(0, 1), cA + hstep, voffA);
        if (wr == 1) PG8_BAR;
        PG8_WAIT_V(2); PG8_BAR;
        PG8_STAGE(PG8_SB(1, 0), cB + kstep, voffB); PG8_STAGE(PG8_SA(1, 0), cA + kstep, voffA); PG8_STAGE(PG8_SB(1, 1), cB + hstep + kstep, voffB);
        PG8_WAIT_V(6); PG8_BAR;
    } else {
        PG8_STAGE(PG8_SB(0, 0), cB, voffB); PG8_STAGE(PG8_SA(0, 0), cA, voffA); PG8_STAGE(PG8_SB(0, 1), cB + hstep, voffB); PG8_STAGE(PG8_SA(0, 1), cA + hstep, voffA);
        if (wr == 1) PG8_BAR;
        PG8_WAIT_V(4); PG8_BAR;
        PG8_STAGE(PG8_SB(1, 0), cB + kstep, voffB); PG8_STAGE(PG8_SA(1, 0), cA + kstep, voffA); PG8_STAGE(PG8_SB(1, 1), cB + hstep + kstep, voffB);
        PG8_WAIT_V(6); PG8_BAR;
    }
    for (;;) {
        const bool has_next = S.next(ui + 1, nxt);
        const char* nA = has_next ? (const char*)g.A + (size_t)nxt.pm * tstep : cA; const char* nB = has_next ? (const char*)g.Bt + (size_t)nxt.pn * tstep : cB;
        for (int t = 0; t < nt; t += 2) {
            const bool last = (t == nt - 2);
            const char* a1 = cA + (size_t)(t + 1) * kstep;
            const char* a2 = last ? nA : cA + (size_t)(t + 2) * kstep; const char* b2 = last ? nB : cB + (size_t)(t + 2) * kstep;
            const char* a3 = a2 + kstep; const char* b3 = b2 + kstep;
            if (last && has_next) S.a_ready(nxt);
            if constexpr (SP2) {
            PG8_LDB(B0, 0, 0); PG8_LDB(B1, 0, 1); PG8_SCHED; PG8_LDA(At, 0, 0); PG8_STAGE(PG8_SA(1, 1), a1 + hstep, voffA);
            PG8_WAIT_V(8); PG8_WAIT_L(0); PG8_BAR; PG8_MMA(0, 0, At, B0); PG8_MMA(0, 1, At, B1); PG8_BAR; PG8_SCHED;
            PG8_LDA(At, 0, 1); PG8_STAGE(PG8_SB(0, 0), b2, voffB); PG8_STAGE(PG8_SB(0, 1), b2 + hstep, voffB); PG8_STAGE(PG8_SA(0, 0), a2, voffA);
            PG8_WAIT_V(8); PG8_WAIT_L(0); PG8_BAR; PG8_MMA(1, 0, At, B0); PG8_MMA(1, 1, At, B1); PG8_BAR; PG8_SCHED;
            PG8_LDB(B0, 1, 0); PG8_LDB(B1, 1, 1); PG8_SCHED; PG8_LDA(At, 1, 0); PG8_STAGE(PG8_SA(0, 1), a2 + hstep, voffA);
            PG8_WAIT_V(8); PG8_WAIT_L(0); PG8_BAR; PG8_MMA(0, 0, At, B0); PG8_MMA(0, 1, At, B1); PG8_BAR; PG8_SCHED;
            PG8_LDA(At, 1, 1); PG8_STAGE(PG8_SB(1, 0), b3, voffB); PG8_STAGE(PG8_SB(1, 1), b3 + hstep, voffB); PG8_STAGE(PG8_SA(1, 0), a3, voffA);
            PG8_WAIT_V(8); PG8_WAIT_L(0); PG8_BAR; PG8_MMA(1, 0, At, B0); PG8_MMA(1, 1, At, B1); PG8_BAR; PG8_SCHED;
            } else {
            PG8_LDB(B0, 0, 0); PG8_SCHED; PG8_LDA(At, 0, 0); PG8_STAGE(PG8_SA(1, 1), a1 + hstep, voffA);
            PG8_WAIT_L(8); PG8_BAR; PG8_WAIT_L(0); PG8_MMA(0, 0, At, B0); PG8_BAR; PG8_SCHED;
            PG8_LDB(B1, 0, 1); PG8_STAGE(PG8_SB(0, 0), b2, voffB);
            PG8_BAR; PG8_WAIT_L(0); PG8_MMA(0, 1, At, B1); PG8_BAR;
            PG8_LDA(At, 0, 1); PG8_STAGE(PG8_SA(0, 0), a2, voffA);
            PG8_BAR; PG8_WAIT_L(0); PG8_MMA(1, 0, At, B0); PG8_BAR; PG8_SCHED;
            PG8_STAGE(PG8_SB(0, 1), b2 + hstep, voffB);
            PG8_WAIT_V(6); PG8_BAR; PG8_MMA(1, 1, At, B1); PG8_BAR;
            PG8_LDB(B0, 1, 0); PG8_SCHED; PG8_LDA(At, 1, 0); PG8_STAGE(PG8_SA(0, 1), a2 + hstep, voffA);
            PG8_WAIT_L(8); PG8_BAR; PG8_WAIT_L(0); PG8_MMA(0, 0, At, B0); PG8_BAR; PG8_SCHED;
            PG8_LDB(B1, 1, 1); PG8_STAGE(PG8_SB(1, 0), b3, voffB);
            PG8_BAR; PG8_WAIT_L(0); PG8_MMA(0, 1, At, B1); PG8_BAR;
            PG8_LDA(At, 1, 1); PG8_STAGE(PG8_SA(1, 0), a3, voffA);
            PG8_BAR; PG8_WAIT_L(0); PG8_MMA(1, 0, At, B0); PG8_BAR; PG8_SCHED;
            PG8_STAGE(PG8_SB(1, 1), b3 + hstep, voffB);
            PG8_WAIT_V(6); PG8_BAR; PG8_MMA(1, 1, At, B1); PG8_BAR;
            }
        }
        if constexpr (ALIGN_EPI) { if (wr == 0) PG8_BAR; }
        if constexpr (!Epi::AFTER_DRAIN) { E(acc, cur, wr, wc, fr, fq); S.done(cur); }
        if (!has_next) break;
#pragma unroll
        for (int a = 0; a < 2; ++a)
#pragma unroll
            for (int b = 0; b < 2; ++b)
#pragma unroll
                for (int m = 0; m < 4; ++m)
#pragma unroll
                    for (int n = 0; n < 2; ++n) acc[a][b][m][n] = (f32x4){0.f, 0.f, 0.f, 0.f};
        cur = nxt; cA = nA; cB = nB; ++ui;
        if constexpr (ALIGN_EPI) { if (wr == 1) PG8_BAR; }
    }
    PG8_WAIT_V(0);
    if constexpr (!ALIGN_EPI) { if (wr == 0) PG8_BAR; }
    PG8_BAR;
    if constexpr (Epi::AFTER_DRAIN) { E.fused(acc, cur, wr, wc, fr, fq, lds, wid, lane); S.done(cur); }
#undef PG8_SA
#undef PG8_SB
#undef PG8_STAGE
#undef PG8_LDA
#undef PG8_LDB
#undef PG8_MMA
#undef PG8_WAIT_V
#undef PG8_WAIT_L
#undef PG8_BAR
#undef PG8_SCHED
}
}

#ifndef REP_G1
#define REP_G1 1
#endif
#ifndef REP_G2
#define REP_G2 1
#endif
#ifndef REP_G3
#define REP_G3 1
#endif
#ifndef ATT_VAR
#define ATT_VAR -1
#endif
#ifndef REP_ATTN
#define REP_ATTN 1
#endif
#ifndef REP_SMALL
#define REP_SMALL 1
#endif
constexpr int NB = 8, SEQ = 4096, DM = 1024, NH = 8, HD = 64, M_TOK = NB * SEQ;
constexpr int EVEN_W = 4104, FLOG_COL = 1536, MOBA_COL = 1544, GATE_COL = 3080;
constexpr int NWAVES = 8, NTHREADS = 512;
constexpr int LDS_BYTES = 147456;

constexpr size_t MiB = (size_t)1 << 20;
constexpr size_t WS_W0T = 0, WS_WO0T = 8 * MiB, WS_W1T = 10 * MiB, WS_WO1T = 16 * MiB;
constexpr size_t WS_RSTD0 = 18 * MiB, WS_LOGF = 19 * MiB, WS_CUM = 20 * MiB, WS_KMEAN = 21 * MiB, WS_GAINS = 21 * MiB + 256 * 1024, WS_ROPE = 21 * MiB + 512 * 1024, WS_SSQP = 22 * MiB, WS_BAR = 24 * MiB, WS_KMP = 25 * MiB, WS_KX = 26 * MiB;
constexpr size_t WS_XB = 32 * MiB;
constexpr size_t WS_QKV = 96 * MiB;
constexpr size_t WS_SG = 288 * MiB, WS_MIX = 352 * MiB, WS_END = 416 * MiB;
constexpr size_t WS_U = 96 * MiB, WS_SZ = 160 * MiB, WS_A2 = 224 * MiB;

#define LAS __attribute__((address_space(3)))
typedef unsigned short bf16;
typedef float f32x4 __attribute__((ext_vector_type(4)));
typedef float f32x2 __attribute__((ext_vector_type(2)));
typedef float f32x16 __attribute__((ext_vector_type(16)));
typedef short bf16x8 __attribute__((ext_vector_type(8)));
typedef short s16x4 __attribute__((ext_vector_type(4)));
typedef unsigned u32x4 __attribute__((ext_vector_type(4)));
typedef unsigned u32x2 __attribute__((ext_vector_type(2)));
typedef __bf16 bf16x2_t __attribute__((ext_vector_type(2)));

__device__ __forceinline__ unsigned cvtpk(float lo, float hi) { f32x2 v = {lo, hi}; bf16x2_t b = __builtin_convertvector(v, bf16x2_t); return __builtin_bit_cast(unsigned, b); }
__device__ __forceinline__ float bflo(unsigned w) { return __uint_as_float(w << 16); }
__device__ __forceinline__ float bfhi(unsigned w) { return __uint_as_float(w & 0xffff0000u); }
__device__ __forceinline__ float dpp_add(float v, const int ctrl_tag) {
    int r;
    if (ctrl_tag == 0) r = __builtin_amdgcn_update_dpp(0, __builtin_bit_cast(int, v), 0xB1, 0xf, 0xf, false);
    else if (ctrl_tag == 1) r = __builtin_amdgcn_update_dpp(0, __builtin_bit_cast(int, v), 0x4E, 0xf, 0xf, false);
    else if (ctrl_tag == 2) r = __builtin_amdgcn_update_dpp(0, __builtin_bit_cast(int, v), 0x141, 0xf, 0xf, false);
    else r = __builtin_amdgcn_update_dpp(0, __builtin_bit_cast(int, v), 0x140, 0xf, 0xf, false);
    return v + __builtin_bit_cast(float, r);
}
__device__ __forceinline__ float row_sum16(float v) { v = dpp_add(v, 0); v = dpp_add(v, 1); v = dpp_add(v, 2); v = dpp_add(v, 3); return v; }
__device__ __forceinline__ float wave_sum(float v) {
    v = dpp_add(v, 0); v = dpp_add(v, 1); v = dpp_add(v, 2); v = dpp_add(v, 3);
    v += __shfl_xor(v, 16); v += __shfl_xor(v, 32);
    return v;
}
__device__ __forceinline__ int crow(int r, int hi) { return (r & 3) + 8 * (r >> 2) + 4 * hi; }

__device__ __forceinline__ int lane_id() { return (int)(__builtin_amdgcn_mbcnt_hi(~0u, __builtin_amdgcn_mbcnt_lo(~0u, 0u)) & 63u); }
#define XB_TMO      128
#define XB_XCNT(j)  (256  + 64 * (j))
#define XB_XSUB(j)  (1280 + 64 * (j))
#define XB_XGEN(j)  (2304 + 64 * (j))
#define XB_TOP      3328
#define XB_TOPGEN   3392
#define XCD_BAR_WORDS 3456
#define XB_SPIN_CAP (1u << 18)

__device__ __forceinline__ unsigned xb_ld(unsigned* p)              { return __hip_atomic_load(p, __ATOMIC_RELAXED, __HIP_MEMORY_SCOPE_AGENT); }
__device__ __forceinline__ unsigned xb_add(unsigned* p, unsigned v) { return __hip_atomic_fetch_add(p, v, __ATOMIC_RELAXED, __HIP_MEMORY_SCOPE_AGENT); }
__device__ __forceinline__ unsigned xb_xcc_id() { return (unsigned)__builtin_amdgcn_s_getreg((3 << 11) | 20) & 0xFu; }
#define XB_SPIN(cond, bar) do { unsigned _sp = 0; while (cond) { __builtin_amdgcn_s_sleep(1); \
    if ((++_sp & 255u) == 0u) { if (xb_ld(&(bar)[XB_TMO])) break; if (_sp > XB_SPIN_CAP) { atomicAdd(&(bar)[XB_TMO], 1u); break; } } } } while (0)

struct XcdBarrier {
    unsigned* bar; unsigned x; int wave;
    volatile LAS unsigned* st;
};

__device__ __forceinline__ XcdBarrier xcd_barrier_post(unsigned* bar, volatile LAS unsigned* st, int wave) {
    XcdBarrier b; b.bar = bar; b.x = xb_xcc_id(); b.st = st; b.wave = wave;
    if (wave == 0 && lane_id() == 0) (void)xb_add(&bar[XB_XCNT(b.x)], 1u);
    return b;
}
__device__ __forceinline__ void xcd_barrier_complete(unsigned* bar, unsigned x, unsigned& nloc, unsigned& nx) {
    const unsigned G = gridDim.x * gridDim.y * gridDim.z;
    unsigned sum, cnt, mine, sp = 0u;
    for (;;) {
        sum = 0u; cnt = 0u; mine = 0u;
#pragma unroll
        for (unsigned j = 0; j < 16; ++j) { const unsigned c = xb_ld(&bar[XB_XCNT(j)]); sum += c; cnt += (c > 0u) ? 1u : 0u; mine = (j == x) ? c : mine; }
        if (sum == G) break;
        __builtin_amdgcn_s_sleep(1);
        if ((++sp & 255u) == 0u) { if (xb_ld(&bar[XB_TMO])) break; if (sp > XB_SPIN_CAP) { atomicAdd(&bar[XB_TMO], 1u); break; } }
    }
    nloc = mine > 0u ? mine : 1u; nx = cnt > 0u ? cnt : 1u;
}

__device__ __forceinline__ void xcd_barrier(const XcdBarrier& b) {
    asm volatile("s_waitcnt vmcnt(0)" ::: "memory");
    __syncthreads();
    if (b.wave == 0 && lane_id() == 0) {
        unsigned* bar = b.bar;
        __builtin_amdgcn_s_waitcnt(0);
        unsigned nloc = b.st[0], nx = b.st[1];
        if (nloc == 0u) { xcd_barrier_complete(bar, b.x, nloc, nx); b.st[0] = nloc; b.st[1] = nx; }
        const unsigned old = xb_add(&bar[XB_XSUB(b.x)], 1u);
        const unsigned gen = old / nloc;
        if (old + 1u == (gen + 1u) * nloc) {
            __builtin_amdgcn_fence(__ATOMIC_RELEASE, "agent");
            asm volatile("s_waitcnt vmcnt(0)" ::: "memory");
            const unsigned og = xb_add(&bar[XB_TOP], 1u);
            const unsigned tg = og / nx;
            if (og + 1u == (tg + 1u) * nx) xb_add(&bar[XB_TOPGEN], 1u);
            else XB_SPIN(xb_ld(&bar[XB_TOPGEN]) == tg, bar);
            __builtin_amdgcn_fence(__ATOMIC_ACQUIRE, "agent");
            xb_add(&bar[XB_XGEN(b.x)], 1u);
            asm volatile("s_waitcnt vmcnt(0)" ::: "memory");
        } else {
            XB_SPIN(xb_ld(&bar[XB_XGEN(b.x)]) == gen, bar);
            __builtin_amdgcn_fence(__ATOMIC_ACQUIRE, "agent");
            asm volatile("s_waitcnt vmcnt(0)" ::: "memory");
        }
    }
    __syncthreads();
}

struct Args { const float* in[16]; float* out; unsigned char* ws; int ph_lo, ph_hi, coop, pad; };

__device__ __forceinline__ void transpose_item(const float* W, int K, int Nsrc, const float* kscale, bf16* WT, LAS float* scr, int k0, int n0, int src0, int lane) {
    float wv[32];
#pragma unroll
    for (int i = 0; i < 32; ++i) { const int kk = 2 * i + (lane >> 5); wv[i] = W[(size_t)(k0 + kk) * Nsrc + src0 + (lane & 31)]; }
#pragma unroll
    for (int i = 0; i < 32; ++i) { const int kk = 2 * i + (lane >> 5); float w = wv[i]; if (kscale) w *= kscale[k0 + kk]; scr[kk * 33 + (lane & 31)] = w; }
    asm volatile("s_waitcnt lgkmcnt(0)" ::: "memory");
    const int c = lane & 7;
#pragma unroll
    for (int j = 0; j < 4; ++j) { const int n = (lane >> 3) + 8 * j; const LAS float* s = scr + (8 * c) * 33 + n;
        u32x4 o; o.x = cvtpk(s[0 * 33], s[1 * 33]); o.y = cvtpk(s[2 * 33], s[3 * 33]); o.z = cvtpk(s[4 * 33], s[5 * 33]); o.w = cvtpk(s[6 * 33], s[7 * 33]);
        *(u32x4*)(WT + (size_t)(n0 + n) * K + k0 + 8 * c) = o; }
    asm volatile("s_waitcnt lgkmcnt(0)" ::: "memory");
}
__device__ __forceinline__ int src_col_l0(int np) {
    const int pn = np >> 8, cp = np & 255;
    if (pn >= 12) return GATE_COL + (np - 3072);
    const int s = pn >> 1, bj = cp >> 7, wc = (cp >> 5) & 3, j = cp & 31, head = 4 * (pn & 1) + wc, d = 32 * bj + j;
    const int base = (s < 3) ? s * 512 : MOBA_COL + (s - 3) * 512;
    return base + head * 64 + d;
}
__device__ __forceinline__ int src_col_l1(int np) {
    const int pn = np >> 8, cp = np & 255;
    if (pn >= 8) return 2048 + (np - 2048);
    return ((cp >> 7) ? 1024 : 0) + pn * 128 + (cp & 127);
}

__device__ __forceinline__ void phase_prologue(const Args& a, LAS unsigned char* lds, int wave_s) {
    const int lane = lane_id(), wave = wave_s, tid = wave_s * 64 + lane;
    const int G = gridDim.x, gw = blockIdx.x * NWAVES + wave, NGW = G * NWAVES;
    unsigned char* ws = a.ws;
    const float* x = a.in[0]; const float* l0_norm = a.in[1]; const float* l0_w_in = a.in[2]; const float* l0_b_f = a.in[3];
    const float* l0_w_out = a.in[8]; const float* l1_norm = a.in[9]; const float* l1_w_in = a.in[10]; const float* l1_w_out = a.in[15];
    if (blockIdx.x == 0 && tid < 256) { const int k = tid >> 6; const float* src = (k == 0) ? a.in[4] : (k == 1) ? a.in[5] : (k == 2) ? a.in[6] : a.in[7]; ((float*)(ws + WS_GAINS))[tid] = src[tid & 63]; }
    LAS float* wfl = (LAS float*)(lds + 73728);
    {   float wa[16], wb[16];
#pragma unroll
        for (int j = 0; j < 16; ++j) { const int i = tid + j * NTHREADS, k = i >> 3, h = i & 7; wa[j] = l0_w_in[(size_t)k * EVEN_W + FLOG_COL + h]; wb[j] = l0_norm[k]; }
#pragma unroll
        for (int j = 0; j < 16; ++j) wfl[tid + j * NTHREADS] = wa[j] * wb[j]; }
    LAS float* scr = (LAS float*)(lds + wave * 8448);
    constexpr int I0 = 16 * 128, I1 = 16 * 32, I2 = 16 * 96, I3 = 16 * 32;
    for (int it = gw; it < I0 + I1 + I2 + I3; it += NGW) {
        int r = it;
        if (r < I0) { const int kb = r / 128, nb = r % 128; transpose_item(l0_w_in, 1024, EVEN_W, l0_norm, (bf16*)(ws + WS_W0T), scr, 64 * kb, 32 * nb, src_col_l0(32 * nb), lane); continue; } r -= I0;
        if (r < I1) { const int kb = r / 32, nb = r % 32; transpose_item(l0_w_out, 1024, 1024, nullptr, (bf16*)(ws + WS_WO0T), scr, 64 * kb, 32 * nb, 32 * nb, lane); continue; } r -= I1;
        if (r < I2) { const int kb = r / 96, nb = r % 96; transpose_item(l1_w_in, 1024, 3072, l1_norm, (bf16*)(ws + WS_W1T), scr, 64 * kb, 32 * nb, src_col_l1(32 * nb), lane); continue; } r -= I2;
        { const int kb = r / 32, nb = r % 32; transpose_item(l1_w_out, 1024, 1024, nullptr, (bf16*)(ws + WS_WO1T), scr, 64 * kb, 32 * nb, 32 * nb, lane); }
    }
    { float* rope = (float*)(ws + WS_ROPE);
      for (int i = blockIdx.x * NTHREADS + tid; i < SEQ * 8; i += G * NTHREADS) {
          const int pos = i >> 3, k = i & 7;
          const float inv_freq = exp2f(-(float)k * (18.931568569324174f / 8.0f));
          const float ang = (float)pos * inv_freq;
          const double rev = (double)ang * 0.15915494309189535;
          const float fr = (float)(rev - floor(rev));
          rope[2 * i] = __builtin_amdgcn_cosf(fr); rope[2 * i + 1] = __builtin_amdgcn_sinf(fr);
      } }
    __syncthreads();
    float* rstd0 = (float*)(ws + WS_RSTD0); float* logf = (float*)(ws + WS_LOGF); bf16* xb = (bf16*)(ws + WS_XB);
    f32x4 nv[4];
    if (gw < M_TOK) { const f32x4* xr0 = (const f32x4*)(x + (size_t)gw * DM) + lane;
#pragma unroll
        for (int j = 0; j < 4; ++j) nv[j] = xr0[64 * j]; }
    for (int m = gw; m < M_TOK; m += NGW) {
        f32x4 v[4]; float s = 0.f;
#pragma unroll
        for (int j = 0; j < 4; ++j) v[j] = nv[j];
        if (m + NGW < M_TOK) { const f32x4* xr = (const f32x4*)(x + (size_t)(m + NGW) * DM) + lane;
#pragma unroll
            for (int j = 0; j < 4; ++j) nv[j] = xr[64 * j]; }
#pragma unroll
        for (int j = 0; j < 4; ++j) s += (v[j].x * v[j].x + v[j].y * v[j].y) + (v[j].z * v[j].z + v[j].w * v[j].w);
        const float rstd = 1.0f / sqrtf(wave_sum(s) * (1.0f / DM) + 1e-6f);
        u32x2* o8 = (u32x2*)(xb + (size_t)m * DM) + lane;
        float fl[8];
#pragma unroll
        for (int h = 0; h < 8; ++h) fl[h] = 0.f;
#pragma unroll
        for (int j = 0; j < 4; ++j) {
            u32x2 pk; pk.x = cvtpk(v[j].x, v[j].y); pk.y = cvtpk(v[j].z, v[j].w); o8[64 * j] = pk;
#pragma unroll
            for (int e = 0; e < 4; ++e) {
                const LAS f32x4* wp = (const LAS f32x4*)(wfl + (256 * j + 4 * lane + e) * 8);
                const f32x4 w0 = wp[0], w1 = wp[1]; const float xv = v[j][e];
                fl[0] += xv * w0.x; fl[1] += xv * w0.y; fl[2] += xv * w0.z; fl[3] += xv * w0.w;
                fl[4] += xv * w1.x; fl[5] += xv * w1.y; fl[6] += xv * w1.z; fl[7] += xv * w1.w;
            }
        }
        float mine = 0.f;
#pragma unroll
        for (int h = 0; h < 8; ++h) { const float t_ = row_sum16(fl[h]); if ((lane & 15) == h) mine = t_; }
        mine += __shfl_xor(mine, 16); mine += __shfl_xor(mine, 32);
        if (lane == 0) rstd0[m] = rstd;
        if (lane < 8) {
            const float f = mine * rstd + l0_b_f[lane];
            const float ls = fminf(f, 0.f) - log1pf(__expf(-fabsf(f)));
            logf[((size_t)((m >> 12) * 8 + lane)) * SEQ + (m & 4095)] = ls;
        }
    }
}

__device__ __forceinline__ void cumsum_item(const float* logf, float* cum2, bf16* kx, int seq, LAS unsigned char* lds, int wave_s) {
    const int lane = lane_id(), wave = wave_s, tid = wave_s * 64 + lane;
    const f32x4* p = (const f32x4*)(logf + (size_t)seq * SEQ + tid * 8);
    const f32x4 a = p[0], b = p[1];
    float v[8] = {a.x, a.y, a.z, a.w, b.x, b.y, b.z, b.w};
#pragma unroll
    for (int i = 1; i < 8; ++i) v[i] += v[i - 1];
    float sc = v[7];
#pragma unroll
    for (int o = 1; o < 64; o <<= 1) { const float y = __shfl_up(sc, o); if (lane >= o) sc += y; }
    LAS float* wt = (LAS float*)lds;
    __syncthreads();
    if (lane == 63) wt[wave] = sc;
    __syncthreads();
    float off = sc - v[7];
    for (int w = 0; w < wave; ++w) off += wt[w];
    constexpr float L2E = 1.4426950408889634f;
    f32x4 o0 = {(v[0] + off) * L2E, (v[1] + off) * L2E, (v[2] + off) * L2E, (v[3] + off) * L2E}, o1 = {(v[4] + off) * L2E, (v[5] + off) * L2E, (v[6] + off) * L2E, (v[7] + off) * L2E};
    {
        u32x4* kxp = (u32x4*)(kx + ((size_t)seq * SEQ + tid * 8) * 8);
#pragma unroll
        for (int i = 0; i < 8; ++i) { const float nc = -((v[i] + off) * L2E);
            const unsigned h = cvtpk(nc, 0.f) & 0xffffu; const float r1 = nc - __uint_as_float(h << 16);
            const unsigned m = cvtpk(r1, 0.f) & 0xffffu; const float r2 = r1 - __uint_as_float(m << 16);
            const unsigned l = cvtpk(r2, 0.f) & 0xffffu;
            kxp[i] = (u32x4){h | (m << 16), l | 0x3F800000u, 0x3F803F80u, 0u}; } }
    f32x4* q = (f32x4*)(cum2 + (size_t)seq * SEQ + tid * 8); q[0] = o0; q[1] = o1;
    __syncthreads();
}

__device__ __forceinline__ void kmean_phase(const bf16* KM, float* kmean, LAS unsigned char* lds, int wave_s) {
    const int tid = wave_s * 64 + lane_id(), row = tid >> 3, ch = tid & 7;
    LAS float* red = (LAS float*)lds;
    for (int item = blockIdx.x; item < 64 * 16; item += gridDim.x) {
        const bf16* kp = KM + ((size_t)(item >> 4) * SEQ + (item & 15) * 256) * 64;
        float acc[8];
#pragma unroll
        for (int j = 0; j < 8; ++j) acc[j] = 0.f;
#pragma unroll
        for (int i = 0; i < 4; ++i) { const u32x4 v = *(const u32x4*)(kp + (size_t)(row + 64 * i) * 64 + ch * 8);
            acc[0] += bflo(v.x); acc[1] += bfhi(v.x); acc[2] += bflo(v.y); acc[3] += bfhi(v.y); acc[4] += bflo(v.z); acc[5] += bfhi(v.z); acc[6] += bflo(v.w); acc[7] += bfhi(v.w); }
        *(LAS f32x4*)(red + row * 64 + ch * 8) = (f32x4){acc[0], acc[1], acc[2], acc[3]};
        *(LAS f32x4*)(red + row * 64 + ch * 8 + 4) = (f32x4){acc[4], acc[5], acc[6], acc[7]};
        __syncthreads();
        if (tid < 64) { float s = 0.f;
#pragma unroll 8
            for (int r = 0; r < 64; ++r) s += red[r * 64 + tid];
            kmean[(size_t)item * 64 + tid] = s * (1.0f / 256.0f); }
        __syncthreads();
    }
}

constexpr int AT_STG = 18688, AT_KPL = 1040, AT_VPL = 4160, AT_VOF = 8320, AT_KXO = 16640;
constexpr int AT_SEL = 3 * AT_STG, AT_KM = AT_SEL + 1024, AT_WL = AT_KM + 4096, AT_OST = AT_WL + 1024, AT_CK = AT_OST + 32768;
typedef short v4i16_t __attribute__((ext_vector_type(4)));
__device__ __forceinline__ s16x4 vtr(const LAS unsigned char* p) { return __builtin_bit_cast(s16x4, __builtin_amdgcn_ds_read_tr16_b64_v4i16((LAS v4i16_t*)p)); }

__device__ __forceinline__ void s_tile(f32x16& c0, f32x16& c1, const LAS unsigned char* Kb, const bf16x8 (&qr)[4]) {
#pragma unroll
    for (int d0 = 0; d0 < 4; ++d0) {
        const bf16x8 b0 = *(const LAS bf16x8*)(Kb + d0 * 2048), b1 = *(const LAS bf16x8*)(Kb + d0 * 2048 + 512);
        c0 = __builtin_amdgcn_mfma_f32_32x32x16_bf16(b0, qr[d0], c0, 0, 0, 0);
        c1 = __builtin_amdgcn_mfma_f32_32x32x16_bf16(b1, qr[d0], c1, 0, 0, 0);
    }
}
__device__ __forceinline__ void fox_init(f32x16& c0, f32x16& c1, const LAS float* ck, float cq2, int hi) {
#pragma unroll
    for (int g = 0; g < 4; ++g) { const f32x4 a = *(const LAS f32x4*)(ck + 8 * g + 4 * hi), bb = *(const LAS f32x4*)(ck + 32 + 8 * g + 4 * hi);
#pragma unroll
        for (int e = 0; e < 4; ++e) { c0[4 * g + e] = cq2 - a[e]; c1[4 * g + e] = cq2 - bb[e]; } }
}
__device__ __forceinline__ void causal_mask(f32x16& c0, f32x16& c1, int jb, int qrel, int hi) {
    const int kb = 64 * jb + 4 * hi;
#pragma unroll
    for (int r = 0; r < 16; ++r) { const int kv = kb + (r & 3) + 8 * (r >> 2); if (kv > qrel) c0[r] = -INFINITY; if (kv + 32 > qrel) c1[r] = -INFINITY; }
}
__device__ __forceinline__ float exp_tile(f32x16& c0, f32x16& c1, u32x4 (&pw)[4]) {
    float ps = 0.f;
#pragma unroll
    for (int r = 0; r < 16; ++r) { c0[r] = __builtin_amdgcn_exp2f(c0[r]); c1[r] = __builtin_amdgcn_exp2f(c1[r]); ps += c0[r] + c1[r]; }
#pragma unroll
    for (int s = 0; s < 2; ++s) {
        pw[s] = (u32x4){cvtpk(c0[8 * s], c0[8 * s + 1]), cvtpk(c0[8 * s + 2], c0[8 * s + 3]), cvtpk(c0[8 * s + 4], c0[8 * s + 5]), cvtpk(c0[8 * s + 6], c0[8 * s + 7])};
        pw[2 + s] = (u32x4){cvtpk(c1[8 * s], c1[8 * s + 1]), cvtpk(c1[8 * s + 2], c1[8 * s + 3]), cvtpk(c1[8 * s + 4], c1[8 * s + 5]), cvtpk(c1[8 * s + 6], c1[8 * s + 7])};
    }
    return ps;
}
__device__ __forceinline__ void pv_tile(f32x16& o0, f32x16& o1, const u32x4 (&pw)[4], const LAS unsigned char* vb) {
#pragma unroll
    for (int ks = 0; ks < 4; ++ks) {
        const bf16x8 pa = __builtin_bit_cast(bf16x8, pw[ks]);
        { const s16x4 lo = vtr(vb + ks * 1024), hh = vtr(vb + ks * 1024 + 512);
          const bf16x8 vf = {lo[0], lo[1], lo[2], lo[3], hh[0], hh[1], hh[2], hh[3]};
          o0 = __builtin_amdgcn_mfma_f32_32x32x16_bf16(pa, vf, o0, 0, 0, 0); }
        { const s16x4 lo = vtr(vb + 4096 + ks * 1024), hh = vtr(vb + 4096 + ks * 1024 + 512);
          const bf16x8 vf = {lo[0], lo[1], lo[2], lo[3], hh[0], hh[1], hh[2], hh[3]};
          o1 = __builtin_amdgcn_mfma_f32_32x32x16_bf16(pa, vf, o1, 0, 0, 0); }
    }
}

template <bool FOX, int VAR = 0>
__device__ __forceinline__ void attn_unit(LAS unsigned char* lds, int b, int h, int qb, const bf16* Q, const bf16* K, const bf16* V, const float* cum2, const float* kmean,
                                          const bf16* sg, bf16* mix, float ref2, int wave_s,
                                          bf16x8 (&qr)[4], u32x4& pk0, u32x4& pv0, u32x4& pk1, u32x4& pv1, int nbh, int nqb) {
    int lane_o; asm volatile("v_mbcnt_lo_u32_b32 %0, -1, 0\n\tv_mbcnt_hi_u32_b32 %0, -1, %0" : "=v"(lane_o));
    const int lane = lane_o & 63, r32 = lane & 31, hi = lane >> 5, wid = wave_s, tid = wave_s * 64 + lane;
    const int bh = b * 8 + h;
    const bf16* Qh = Q + (size_t)bh * SEQ * 64; const bf16* Kh = K + (size_t)bh * SEQ * 64; const bf16* Vh = V + (size_t)bh * SEQ * 64;
    const int q0 = qb * 256 + wid * 32;
    const int NT = 4 * (qb + 1);
    float cqraw = 0.f; if (FOX) cqraw = cum2[(size_t)bh * SEQ + q0 + r32];
    f32x4 kma[4][2], kmb[4][2];
    if (!FOX) { const float* kmp0 = kmean + ((size_t)bh * 16 + r32) * 64 + hi * 8; const bool kvalid = (r32 < qb);
#pragma unroll
        for (int d0 = 0; d0 < 4; ++d0) { kma[d0][0] = kma[d0][1] = kmb[d0][0] = kmb[d0][1] = (f32x4){0.f, 0.f, 0.f, 0.f};
            if (kvalid) { kma[d0][0] = *(const f32x4*)(kmp0 + d0 * 16); kma[d0][1] = *(const f32x4*)(kmp0 + d0 * 16 + 4); kmb[d0][0] = *(const f32x4*)(kmp0 + 65536 + d0 * 16); kmb[d0][1] = *(const f32x4*)(kmp0 + 65536 + d0 * 16 + 4); } } }
    const int qrel4 = 32 * wid + r32 - 4 * hi;
    const int lrow = tid >> 3, lch = tid & 7;
    const bf16* kg = Kh + (size_t)lrow * 64 + lch * 8; const bf16* vg = Vh + (size_t)lrow * 64 + lch * 8;
    const int koff = lch * AT_KPL + lrow * 16, voff = AT_VOF + (lch >> 2) * AT_VPL + lrow * 64 + (lch & 3) * 16;
    const int vlane = AT_VOF + ((lane >> 4) & 1) * 32 + (lane & 3) * 8 + (4 * hi + ((lane & 15) >> 2)) * 64;
    const int klane = hi * AT_KPL + r32 * 16;
    const bf16* kxg = (const bf16*)((const unsigned char*)cum2 - WS_CUM + WS_KX) + ((size_t)bh * SEQ + lane) * 8;
    u32x4 krw, vrw, kxw = {0u, 0u, 0u, 0u};
    if (FOX) { krw = *(const u32x4*)(kg + 2 * 4096); vrw = *(const u32x4*)(vg + 2 * 4096); if (wid == 0) kxw = *(const u32x4*)(kxg + 2 * 512); }
    {   const u32x4 k0 = pk0, v0 = pv0, k1 = pk1, v1 = pv1;
        if (FOX) { f32x4 c0_ = {0.f, 0.f, 0.f, 0.f}, c1_ = c0_; const int nck = 64 * (qb + 1);
            if (tid < nck) c0_ = *(const f32x4*)(cum2 + (size_t)bh * SEQ + tid * 4);
            if (tid + NTHREADS < nck) c1_ = *(const f32x4*)(cum2 + (size_t)bh * SEQ + (tid + NTHREADS) * 4);
            if (tid < nck) *(LAS f32x4*)(lds + AT_CK + tid * 16) = c0_;
            if (tid + NTHREADS < nck) *(LAS f32x4*)(lds + AT_CK + (tid + NTHREADS) * 16) = c1_; }
        *(LAS u32x4*)(lds + koff) = k0; *(LAS u32x4*)(lds + voff) = v0; *(LAS u32x4*)(lds + AT_STG + koff) = k1; *(LAS u32x4*)(lds + AT_STG + voff) = v1;
        if (FOX) { if (wid == 0) { const u32x4 x0 = *(const u32x4*)(kxg), x1 = *(const u32x4*)(kxg + 512); *(LAS u32x4*)(lds + AT_KXO + lane * 16) = x0; *(LAS u32x4*)(lds + AT_STG + AT_KXO + lane * 16) = x1; }
            if (tid >= 64 && tid < 256) *(LAS u32x4*)(lds + ((tid >> 6) - 1) * AT_STG + AT_KXO + 1024 + (tid & 63) * 16) = (u32x4){0u, 0u, 0u, 0u}; } }
    unsigned sel = 0u;
    if (!FOX) {
        const int own = qb;
        f32x16 gacc;
#pragma unroll
        for (int r = 0; r < 16; ++r) gacc[r] = 0.f;
#pragma unroll
        for (int d0 = 0; d0 < 4; ++d0) {
            const float km[8] = {(kma[d0][0].x + kmb[d0][0].x) * (1.0f / 256.0f), (kma[d0][0].y + kmb[d0][0].y) * (1.0f / 256.0f), (kma[d0][0].z + kmb[d0][0].z) * (1.0f / 256.0f), (kma[d0][0].w + kmb[d0][0].w) * (1.0f / 256.0f),
                                 (kma[d0][1].x + kmb[d0][1].x) * (1.0f / 256.0f), (kma[d0][1].y + kmb[d0][1].y) * (1.0f / 256.0f), (kma[d0][1].z + kmb[d0][1].z) * (1.0f / 256.0f), (kma[d0][1].w + kmb[d0][1].w) * (1.0f / 256.0f)};
            u32x4 hw, lw;
#pragma unroll
            for (int j = 0; j < 4; ++j) { const unsigned h_ = cvtpk(km[2 * j], km[2 * j + 1]); hw[j] = h_; lw[j] = cvtpk(km[2 * j] - bflo(h_), km[2 * j + 1] - bfhi(h_)); }
            gacc = __builtin_amdgcn_mfma_f32_32x32x16_bf16(__builtin_bit_cast(bf16x8, hw), qr[d0], gacc, 0, 0, 0);
            gacc = __builtin_amdgcn_mfma_f32_32x32x16_bf16(__builtin_bit_cast(bf16x8, lw), qr[d0], gacc, 0, 0, 0);
        }
        float g[16];
#pragma unroll
        for (int r = 0; r < 8; ++r) { const auto rr_ = __builtin_amdgcn_permlane32_swap(__float_as_uint(gacc[r]), __float_as_uint(gacc[r]), false, false);
            const int blk_ = (r & 3) + 8 * (r >> 2); g[blk_] = __uint_as_float(rr_[0]); g[blk_ + 4] = __uint_as_float(rr_[1]); }
#pragma unroll
        for (int n = 0; n < 15; ++n) g[n] = (n < own) ? g[n] : -INFINITY;
        unsigned mask = 0u;
#pragma unroll
        for (int n = 0; n < 15; ++n) {
            int rank = 0;
#pragma unroll
            for (int m = 0; m < 15; ++m) { if (m < n) rank += (g[m] >= g[n]) ? 1 : 0; else if (m > n) rank += (g[m] > g[n]) ? 1 : 0; }
            if (rank < 3) mask |= 1u << n;
        }
        sel = mask & ((1u << own) - 1u);
        krw = *(const u32x4*)(kg + 2 * 4096); vrw = *(const u32x4*)(vg + 2 * 4096);
    }
    __syncthreads();
    float cq2 = 0.f;
    bf16x8 qx = {0, 0, 0, 0, 0, 0, 0, 0};
    if (FOX) { cq2 = cqraw - ref2;
        const unsigned h_ = cvtpk(cq2, 0.f) & 0xffffu; const float r1_ = cq2 - __uint_as_float(h_ << 16);
        const unsigned m_ = cvtpk(r1_, 0.f) & 0xffffu; const float r2_ = r1_ - __uint_as_float(m_ << 16);
        const unsigned l_ = cvtpk(r2_, 0.f) & 0xffffu;
        const u32x4 w_ = (hi == 0) ? (u32x4){0x3F803F80u, 0x3F80u | (h_ << 16), m_ | (l_ << 16), 0u} : (u32x4){0u, 0u, 0u, 0u};
        qx = __builtin_bit_cast(bf16x8, w_); }
    f32x16 o0, o1;
#pragma unroll
    for (int r = 0; r < 16; ++r) { o0[r] = 0.f; o1[r] = 0.f; }
    float lsum = 0.f;
#define AT_INIT(N0, N1, TILE) do { const int tile_ = (TILE); \
        if (FOX) { const LAS float* ck_ = (const LAS float*)(lds + AT_CK) + tile_ * 64; \
            _Pragma("unroll") for (int g_ = 0; g_ < 4; ++g_) { const f32x4 a_ = *(const LAS f32x4*)(ck_ + 8 * g_ + 4 * hi), b_ = *(const LAS f32x4*)(ck_ + 32 + 8 * g_ + 4 * hi); \
                _Pragma("unroll") for (int e_ = 0; e_ < 4; ++e_) { N0[4 * g_ + e_] = cq2 - a_[e_]; N1[4 * g_ + e_] = cq2 - b_[e_]; } } } \
        else { _Pragma("unroll") for (int r_ = 0; r_ < 16; ++r_) { N0[r_] = 0.f; N1[r_] = 0.f; } } \
        if (tile_ >= NT - 4) { int q4_ = qrel4; asm volatile("" : "+v"(q4_)); const float thr_ = (float)(q4_ - 64 * (tile_ - (NT - 4)));     \
            _Pragma("unroll") for (int r_ = 0; r_ < 16; ++r_) { const float c_ = (float)((r_ & 3) + 8 * (r_ >> 2)); N0[r_] = fminf(N0[r_], (thr_ - c_) * 1e30f); N1[r_] = fminf(N1[r_], (thr_ - (c_ + 32.0f)) * 1e30f); } } } while (0)
#define AT_KF(KFV, STAGE) do { const LAS unsigned char* kb_ = lds + (STAGE) + klane; \
        _Pragma("unroll") for (int d_ = 0; d_ < 4; ++d_) { KFV[2 * d_] = *(const LAS bf16x8*)(kb_ + d_ * 2 * AT_KPL); KFV[2 * d_ + 1] = *(const LAS bf16x8*)(kb_ + d_ * 2 * AT_KPL + 512); } } while (0)
#define AT_KFH(KFV, STAGE, H) do { int ka_ = (STAGE) + klane + (H) * 4 * AT_KPL; asm volatile("" : "+v"(ka_)); const LAS unsigned char* kb_ = lds + ka_; \
        _Pragma("unroll") for (int d_ = 0; d_ < 2; ++d_) { KFV[4 * (H) + 2 * d_] = *(const LAS bf16x8*)(kb_ + d_ * 2 * AT_KPL); KFV[4 * (H) + 2 * d_ + 1] = *(const LAS bf16x8*)(kb_ + d_ * 2 * AT_KPL + 512); } } while (0)
#define AT_EXP4(P, R0, W, J) do { P[R0] = __builtin_amdgcn_exp2f(P[R0]); P[R0 + 1] = __builtin_amdgcn_exp2f(P[R0 + 1]); P[R0 + 2] = __builtin_amdgcn_exp2f(P[R0 + 2]); P[R0 + 3] = __builtin_amdgcn_exp2f(P[R0 + 3]); \
        ps_ += (P[R0] + P[R0 + 1]) + (P[R0 + 2] + P[R0 + 3]); \
        if (FOX) { W[J] = cvtpk(P[R0], P[R0 + 1]); W[J + 1] = cvtpk(P[R0 + 2], P[R0 + 3]); } else { W[J] = cvtpk(P[R0], P[R0 + 1]) & rmu_; W[J + 1] = cvtpk(P[R0 + 2], P[R0 + 3]) & rmu_; } } while (0)
#define AT_VF(VLO, VHI, STAGE, D0) do { int va_ = (STAGE) + vlane + (D0) * AT_VPL; asm volatile("" : "+v"(va_)); const LAS unsigned char* vb_ = lds + va_; \
        _Pragma("unroll") for (int k_ = 0; k_ < 4; ++k_) { VLO[k_] = vtr(vb_ + k_ * 1024); VHI[k_] = vtr(vb_ + k_ * 1024 + 512); } } while (0)
#define AT_VFRAG(VLO, VHI, k) (bf16x8){VLO[k][0], VLO[k][1], VLO[k][2], VLO[k][3], VHI[k][0], VHI[k][1], VHI[k][2], VHI[k][3]}
#define SB() __builtin_amdgcn_sched_barrier(0)
    f32x16 xa0, xa1, xb0, xb1;
    {   bf16x8 kf[8]; AT_INIT(xa0, xa1, 0); AT_KF(kf, 0);
#pragma unroll
        for (int d0 = 0; d0 < 4; ++d0) { xa0 = __builtin_amdgcn_mfma_f32_32x32x16_bf16(kf[2 * d0], qr[d0], xa0, 0, 0, 0); xa1 = __builtin_amdgcn_mfma_f32_32x32x16_bf16(kf[2 * d0 + 1], qr[d0], xa1, 0, 0, 0); } }
    int s_cur = 0, s_nx1 = AT_STG, s_nx2 = 2 * AT_STG;
    u32x4 kra = krw, vra = vrw, kxa = kxw;
#define MFA(D, A, B) asm volatile("s_nop 1\n\tv_mfma_f32_32x32x16_bf16 %0, %1, %2, %0" : "+v"(D) : "v"(A), "v"(B))
#define MFN(D, A, B) asm volatile("v_mfma_f32_32x32x16_bf16 %0, %1, %2, %0" : "+v"(D) : "v"(A), "v"(B))
#define MFZ(D, A, B) asm volatile("v_mfma_f32_32x32x16_bf16 %0, %1, %2, 0" : "=&v"(D) : "v"(A), "v"(B))
#define AT_PINP(P, R0) asm volatile("" : "+v"(P[R0]), "+v"(P[R0 + 1]), "+v"(P[R0 + 2]), "+v"(P[R0 + 3]))
#define AT_PINW(W, J) asm volatile("" : "+v"(W[J]), "+v"(W[J + 1]))
#define AT_G(P, R0, W, J) do { AT_PINP(P, R0); AT_EXP4(P, R0, W, J); AT_PINW(W, J); } while (0)
#define AT_STEP(FAST, P0, P1, N0, N1, KL, VL, XL, KW, VW, XW, T) do { const int t_s = (T); \
        if (t_s + 3 < NT) { KL = *(const u32x4*)(kg + (size_t)(t_s + 3) * 4096); VL = *(const u32x4*)(vg + (size_t)(t_s + 3) * 4096); \
            if (FOX && wid == 0) XL = *(const u32x4*)(kxg + (size_t)(t_s + 3) * 512); } \
        bf16x8 kf[8], kx0, kx1; s16x4 vlo[4], vhi[4]; u32x4 pw[4]; float ps_ = 0.f; \
        const unsigned rmu_ = (FOX || t_s >= NT - 4 || ((sel >> (t_s >> 2)) & 1u)) ? 0xffffffffu : 0u; \
        if (!(FAST)) AT_INIT(N0, N1, t_s + 1); \
        AT_KFH(kf, s_nx1, 0); \
        if (FOX && (FAST)) { const LAS unsigned char* xb_ = lds + s_nx1 + AT_KXO + hi * 1024 + r32 * 16; kx0 = *(const LAS bf16x8*)(xb_); kx1 = *(const LAS bf16x8*)(xb_ + 512); } \
        SB(); \
        if (FOX && (FAST)) { MFZ(N0, kx0, qx); AT_G(P0, 0, pw[0], 0); MFZ(N1, kx1, qx); AT_G(P0, 4, pw[0], 2); MFN(N0, kf[0], qr[0]); AT_G(P0, 8, pw[1], 0); MFN(N1, kf[1], qr[0]); AT_G(P0, 12, pw[1], 2); } \
        else if (FAST) { MFZ(N0, kf[0], qr[0]); AT_G(P0, 0, pw[0], 0); MFZ(N1, kf[1], qr[0]); AT_G(P0, 4, pw[0], 2); } \
        else { MFA(N0, kf[0], qr[0]); AT_G(P0, 0, pw[0], 0); MFA(N1, kf[1], qr[0]); AT_G(P0, 4, pw[0], 2); } \
        AT_KFH(kf, s_nx1, 1); \
        MFN(N0, kf[2], qr[1]); if (!(FOX && (FAST))) AT_G(P0, 8, pw[1], 0); \
        MFN(N1, kf[3], qr[1]); if (!(FOX && (FAST))) AT_G(P0, 12, pw[1], 2); \
        AT_VF(vlo, vhi, s_cur, 0); \
        MFN(N0, kf[4], qr[2]); AT_G(P1, 0, pw[2], 0); \
        MFN(N1, kf[5], qr[2]); AT_G(P1, 4, pw[2], 2); \
        MFN(N0, kf[6], qr[3]); AT_G(P1, 8, pw[3], 0); \
        MFN(N1, kf[7], qr[3]); AT_G(P1, 12, pw[3], 2); \
        lsum += FOX ? ps_ : (rmu_ ? ps_ : 0.f); \
        {   s16x4 wlo[4], whi[4]; \
            _Pragma("unroll") for (int ks = 0; ks < 4; ++ks) { const bf16x8 pa_ = __builtin_bit_cast(bf16x8, pw[ks]); const bf16x8 vf_ = AT_VFRAG(vlo, vhi, ks); MFA(o0, pa_, vf_); if (ks == 1) { AT_VF(wlo, whi, s_cur, 1); } } \
            if (t_s + 2 < NT) { *(LAS u32x4*)(lds + s_nx2 + koff) = KW; *(LAS u32x4*)(lds + s_nx2 + voff) = VW; if (FOX && wid == 0) *(LAS u32x4*)(lds + s_nx2 + AT_KXO + lane * 16) = XW; } \
            _Pragma("unroll") for (int ks = 0; ks < 4; ++ks) { const bf16x8 pa_ = __builtin_bit_cast(bf16x8, pw[ks]); const bf16x8 vf_ = AT_VFRAG(wlo, whi, ks); MFA(o1, pa_, vf_); } } \
        asm volatile("s_waitcnt lgkmcnt(0)\n\ts_barrier" ::: "memory");     \
        { const int t_ = s_cur; s_cur = s_nx1; s_nx1 = s_nx2; s_nx2 = t_; } } while (0)
    {   const int npair = (NT - 2) / 2, nfast = (NT / 2 - 3 > 0) ? NT / 2 - 3 : 0;
#pragma unroll 1
        for (int tp = 0; tp < nfast; ++tp) {
            AT_STEP(1, xa0, xa1, xb0, xb1, kra, vra, kxa, krw, vrw, kxw, 2 * tp);
            AT_STEP(1, xb0, xb1, xa0, xa1, krw, vrw, kxw, kra, vra, kxa, 2 * tp + 1);
        }
#pragma unroll 1
        for (int tp = nfast; tp < npair; ++tp) {
            AT_STEP(0, xa0, xa1, xb0, xb1, kra, vra, kxa, krw, vrw, kxw, 2 * tp);
            AT_STEP(0, xb0, xb1, xa0, xa1, krw, vrw, kxw, kra, vra, kxa, 2 * tp + 1);
        }
        AT_STEP(0, xa0, xa1, xb0, xb1, kra, vra, kxa, krw, vrw, kxw, NT - 2);
    }
    asm volatile("s_nop 15\n\ts_nop 7" : "+v"(o0), "+v"(o1), "+v"(xb0), "+v"(xb1));
    int le; asm volatile("v_mbcnt_lo_u32_b32 %0, -1, 0\n\tv_mbcnt_hi_u32_b32 %0, -1, %0" : "=v"(le)); le &= 63;
    const int colbase = (FOX ? h : 8 + h) * 64;
    const int rowe = le >> 3, che = le & 7;
    const size_t gi0 = ((size_t)(b * SEQ + q0 + rowe)) * 1024 + colbase + che * 8;
    u32x4 gvv[4];
#pragma unroll
    for (int i = 0; i < 4; ++i) gvv[i] = *(const u32x4*)(sg + gi0 + (size_t)i * 8 * 1024);
    if (nbh >= 0) {
        const bf16* nQ = Q + (size_t)nbh * SEQ * 64 + (size_t)(nqb * 256 + wid * 32 + (le & 31)) * 64 + (le >> 5) * 8;
#pragma unroll
        for (int d0 = 0; d0 < 4; ++d0) qr[d0] = *(const bf16x8*)(nQ + d0 * 16);
        const size_t no = (size_t)nbh * SEQ * 64 + (size_t)((wid * 64 + le) >> 3) * 64 + (le & 7) * 8;
        pk0 = *(const u32x4*)(K + no); pv0 = *(const u32x4*)(V + no); pk1 = *(const u32x4*)(K + no + 4096); pv1 = *(const u32x4*)(V + no + 4096);
    } else { pk0 = (u32x4){0u, 0u, 0u, 0u}; pv0 = pk0; pk1 = pk0; pv1 = pk0; }
    {
        u32x4 pw[4]; s16x4 vlo[4], vhi[4], wlo[4], whi[4]; float ps_ = 0.f; const unsigned rmu_ = 0xffffffffu;
        AT_VF(vlo, vhi, s_cur, 0); AT_VF(wlo, whi, s_cur, 1);
        AT_EXP4(xb0, 0, pw[0], 0); AT_EXP4(xb0, 4, pw[0], 2); AT_EXP4(xb0, 8, pw[1], 0); AT_EXP4(xb0, 12, pw[1], 2);
        AT_EXP4(xb1, 0, pw[2], 0); AT_EXP4(xb1, 4, pw[2], 2); AT_EXP4(xb1, 8, pw[3], 0); AT_EXP4(xb1, 12, pw[3], 2);
        lsum += ps_;
#pragma unroll
        for (int ks = 0; ks < 4; ++ks) { o0 = __builtin_amdgcn_mfma_f32_32x32x16_bf16(__builtin_bit_cast(bf16x8, pw[ks]), AT_VFRAG(vlo, vhi, ks), o0, 0, 0, 0);
            o1 = __builtin_amdgcn_mfma_f32_32x32x16_bf16(__builtin_bit_cast(bf16x8, pw[ks]), AT_VFRAG(wlo, whi, ks), o1, 0, 0, 0); }
    }
#undef AT_STEP
#undef AT_G
#undef MFA
#undef MFZ
#undef MFN
#undef AT_PINP
#undef AT_PINW
#undef AT_INIT
#undef AT_KF
#undef AT_EXP4
#undef AT_VF
#undef AT_VFRAG
#undef SB
    { auto rr_ = __builtin_amdgcn_permlane32_swap(__float_as_uint(lsum), __float_as_uint(lsum), false, false); lsum = __uint_as_float(rr_[0]) + __uint_as_float(rr_[1]); }
    {   const int r32e = le & 31, hie = le >> 5;
        LAS float* wl = (LAS float*)(lds + AT_WL) + wid * 32;
        if (hie == 0) wl[r32e] = lsum;
        LAS bf16* stg = (LAS bf16*)(lds + AT_OST) + wid * 2048;
        {   const LAS float* wlp = wl + 4 * hie; LAS bf16* sp = stg + (4 * hie) * 64 + r32e;
#pragma unroll
            for (int r = 0; r < 16; ++r) { const int oc = (r & 3) + 8 * (r >> 2); const float rl = __builtin_amdgcn_rcpf(wlp[oc]);
                sp[oc * 64] = (bf16)(cvtpk(o0[r] * rl, 0.f) & 0xffffu); sp[oc * 64 + 32] = (bf16)(cvtpk(o1[r] * rl, 0.f) & 0xffffu); } }
        const LAS bf16* sr = stg + rowe * 64 + che * 8;
#pragma unroll
        for (int i = 0; i < 4; ++i) {
            const u32x4 ov = *(const LAS u32x4*)(sr + i * 8 * 64);
            const size_t gi = gi0 + (size_t)i * 8 * 1024;
            const u32x4 gv = gvv[i];
            u32x4 res;
            res.x = cvtpk(bflo(ov.x) * bflo(gv.x), bfhi(ov.x) * bfhi(gv.x)); res.y = cvtpk(bflo(ov.y) * bflo(gv.y), bfhi(ov.y) * bfhi(gv.y));
            res.z = cvtpk(bflo(ov.z) * bflo(gv.z), bfhi(ov.z) * bfhi(gv.z)); res.w = cvtpk(bflo(ov.w) * bflo(gv.w), bfhi(ov.w) * bfhi(gv.w));
            *(u32x4*)(mix + gi) = res; } }
    __syncthreads();
}

__device__ __forceinline__ float gain_bound(const float* gq, const float* gk) {
    float mq = 0.f, mk = 0.f;
    for (int i = 0; i < 64; ++i) { mq = fmaxf(mq, fabsf(gq[i])); mk = fmaxf(mk, fabsf(gk[i])); }
    return 8.0f * mq * mk * 1.4426950408889634f * 1.02f + 0.25f;
}

#define AT_DECODE(I, BH, QB) do { const int w0_ = (I) & 255, w_ = ((w0_ & 7) << 5) | (w0_ >> 3), k_ = ((I) >> 8) & 3, sub_ = w_ & 3; BH = w_ >> 2; \
        QB = (k_ == 0) ? 15 - sub_ : (k_ == 1) ? 8 + sub_ : (k_ == 2) ? 7 - sub_ : sub_; } while (0)
#define AT_FIRST(QP, KP, VP) bf16x8 qr[4]; u32x4 pk0 = {0u, 0u, 0u, 0u}, pv0 = pk0, pk1 = pk0, pv1 = pk0; \
        if ((int)blockIdx.x < 1024) { int fbh_, fqb_; AT_DECODE((int)blockIdx.x, fbh_, fqb_); const int ln_ = lane_id(); \
            const bf16* fq_ = (QP) + (size_t)fbh_ * SEQ * 64 + (size_t)(fqb_ * 256 + wave_s * 32 + (ln_ & 31)) * 64 + (ln_ >> 5) * 8; \
            _Pragma("unroll") for (int d0 = 0; d0 < 4; ++d0) qr[d0] = *(const bf16x8*)(fq_ + d0 * 16); \
            const size_t fo_ = (size_t)fbh_ * SEQ * 64 + (size_t)((wave_s * 64 + ln_) >> 3) * 64 + (ln_ & 7) * 8; \
            pk0 = *(const u32x4*)((KP) + fo_); pv0 = *(const u32x4*)((VP) + fo_); pk1 = *(const u32x4*)((KP) + fo_ + 4096); pv1 = *(const u32x4*)((VP) + fo_ + 4096); } \
        else { _Pragma("unroll") for (int d0 = 0; d0 < 4; ++d0) qr[d0] = (bf16x8){0, 0, 0, 0, 0, 0, 0, 0}; }
template <int VAR>
__device__ __forceinline__ void attn_phase(const Args& a, LAS unsigned char* lds, int wave_s, size_t mix_off) {
    unsigned char* ws = a.ws;
    const bf16* qkv = (const bf16*)(ws + WS_QKV); const size_t TS = (size_t)16 << 20;
    const float* cum2 = (const float*)(ws + WS_CUM); const float* kmean = (const float*)(ws + WS_KMP);
    const bf16* sg = (const bf16*)(ws + WS_SG); bf16* mix = (bf16*)(ws + mix_off);
    {   const float ref_f = gain_bound(a.in[4], a.in[5]);
        AT_FIRST(qkv, qkv + TS, qkv + 2 * TS);
#pragma unroll 1
        for (int i = blockIdx.x; i < 1024; i += gridDim.x) {
            int bh, qb, nbh = -1, nqb = 0; AT_DECODE(i, bh, qb); if (i + (int)gridDim.x < 1024) AT_DECODE(i + (int)gridDim.x, nbh, nqb);
            attn_unit<true, VAR>(lds, bh >> 3, bh & 7, qb, qkv, qkv + TS, qkv + 2 * TS, cum2, kmean, sg, mix, ref_f, wave_s, qr, pk0, pv0, pk1, pv1, nbh, nqb);
        } }
    {   const float ref_m = gain_bound(a.in[6], a.in[7]);
        AT_FIRST(qkv + 3 * TS, qkv + 4 * TS, qkv + 5 * TS);
#pragma unroll 1
        for (int i = blockIdx.x; i < 1024; i += gridDim.x) {
            int bh, qb, nbh = -1, nqb = 0; AT_DECODE(i, bh, qb); if (i + (int)gridDim.x < 1024) AT_DECODE(i + (int)gridDim.x, nbh, nqb);
            attn_unit<false, VAR>(lds, bh >> 3, bh & 7, qb, qkv + 3 * TS, qkv + 4 * TS, qkv + 5 * TS, cum2, kmean, sg, mix, ref_m, wave_s, qr, pk0, pv0, pk1, pv1, nbh, nqb);
        } }
}

__device__ __forceinline__ void conv_phase(const Args& a, LAS unsigned char* lds, int wave_s) {
    const int lane = lane_id(), wid = wave_s, tid = wave_s * 64 + lane;
    unsigned char* ws = a.ws;
    const bf16* U = (const bf16*)(ws + WS_U); const bf16* SZ = (const bf16*)(ws + WS_SZ); bf16* A2 = (bf16*)(ws + WS_A2);
    const float* cw = a.in[11]; const float* cb = a.in[12]; const float* lg = a.in[13]; const float* lb = a.in[14];
    const int c0 = 2 * tid;
    float w0[31], w1[31];
#pragma unroll
    for (int j = 0; j < 31; ++j) { const f32x2 wv = *(const f32x2*)(cw + j * 1024 + c0); w0[j] = wv.x; w1[j] = wv.y; }
    const f32x2 bias = *(const f32x2*)(cb + c0), gam = *(const f32x2*)(lg + c0), bet = *(const f32x2*)(lb + c0);
    LAS float* red = (LAS float*)(lds + 62 * 2048);
    u32x4 pre[4];
#define CV_LOAD1(DST, ITEM, K) do { const int m0_ = (ITEM) * 32, t0_ = m0_ & 4095; const int idx_ = tid + (K) * NTHREADS, rr_ = idx_ >> 7, ch_ = idx_ & 127; DST = (u32x4){0u, 0u, 0u, 0u}; \
        if (idx_ < 62 * 128 && t0_ - 30 + rr_ >= 0) DST = *(const u32x4*)(U + (size_t)(m0_ - 30 + rr_) * 1024 + ch_ * 8); } while (0)
    const int vcu = ((int)gridDim.x % 8 == 0) ? ((int)blockIdx.x % 8) * ((int)gridDim.x / 8) + (int)blockIdx.x / 8 : (int)blockIdx.x;
    if (vcu < M_TOK / 32) {
#pragma unroll
        for (int k = 0; k < 4; ++k) CV_LOAD1(pre[k], vcu, k); }
    for (int item = vcu; item < M_TOK / 32; item += gridDim.x) {
        const int m0 = item * 32;
        {   u32x4 late[12];
#pragma unroll
            for (int k = 0; k < 12; ++k) CV_LOAD1(late[k], item, 4 + k);
#pragma unroll
            for (int k = 0; k < 4; ++k) { const int idx = tid + k * NTHREADS, rr = idx >> 7, ch = idx & 127; *(LAS u32x4*)(lds + rr * 2048 + ch * 16) = pre[k]; }
#pragma unroll
            for (int k = 4; k < 16; ++k) { const int idx = tid + k * NTHREADS, rr = idx >> 7, ch = idx & 127; if (idx < 62 * 128) *(LAS u32x4*)(lds + rr * 2048 + ch * 16) = late[k - 4]; } }
        __syncthreads();
        if (item + (int)gridDim.x < M_TOK / 32) {
#pragma unroll
            for (int k = 0; k < 4; ++k) CV_LOAD1(pre[k], item + (int)gridDim.x, k); }
#pragma unroll 1
        for (int half = 0; half < 2; ++half) {
            const LAS unsigned char* ub = lds + half * 16 * 2048 + tid * 4;
            float y0[16], y1[16];
#pragma unroll
            for (int k = 0; k < 16; ++k) { y0[k] = bias.x; y1[k] = bias.y; }
#pragma unroll
            for (int rr = 0; rr < 46; ++rr) {
                const unsigned uu = *(const LAS unsigned*)(ub + rr * 2048);
                const float ua = bflo(uu), ub_ = bfhi(uu);
#pragma unroll
                for (int tok = 0; tok < 16; ++tok) { if (rr - tok >= 0 && rr - tok <= 30) { y0[tok] += w0[rr - tok] * ua; y1[tok] += w1[rr - tok] * ub_; } }
            }
            unsigned zz[16];
#pragma unroll
            for (int tok = 0; tok < 16; ++tok) zz[tok] = *(const unsigned*)(SZ + (size_t)(m0 + half * 16 + tok) * 1024 + c0);
            float k1 = 0.f, k2 = 0.f;
#pragma unroll
            for (int tok = 0; tok < 16; ++tok) { const float s1 = row_sum16(y0[tok] + y1[tok]), s2 = row_sum16(y0[tok] * y0[tok] + y1[tok] * y1[tok]); if ((lane & 15) == tok) { k1 = s1; k2 = s2; } }
            k1 += __shfl_xor(k1, 16); k1 += __shfl_xor(k1, 32); k2 += __shfl_xor(k2, 16); k2 += __shfl_xor(k2, 32);
            if (lane < 16) { red[wid * 16 + lane] = k1; red[128 + wid * 16 + lane] = k2; }
            __syncthreads();
            if (tid < 16) { float s1 = 0.f, s2 = 0.f;
#pragma unroll
                for (int w = 0; w < 8; ++w) { s1 += red[w * 16 + tid]; s2 += red[128 + w * 16 + tid]; }
                const float mean = s1 * (1.0f / 1024.0f); const float var = fmaxf(s2 * (1.0f / 1024.0f) - mean * mean, 0.f);
                red[256 + tid] = mean; red[272 + tid] = 1.0f / sqrtf(var + 1e-5f); }
            __syncthreads();
#pragma unroll
            for (int tok = 0; tok < 16; ++tok) {
                const float mean = red[256 + tok], rstd = red[272 + tok];
                float v0 = (y0[tok] - mean) * rstd * gam.x + bet.x, v1 = (y1[tok] - mean) * rstd * gam.y + bet.y;
                v0 = v0 * __builtin_amdgcn_rcpf(1.f + __expf(-v0)); v1 = v1 * __builtin_amdgcn_rcpf(1.f + __expf(-v1));
                const size_t gi = (size_t)(m0 + half * 16 + tok) * 1024 + c0;
                const unsigned z = zz[tok];
                *(unsigned*)(A2 + gi) = cvtpk(v0 * bflo(z), v1 * bfhi(z));
            }
            __syncthreads();
        }
    }
}

__global__ void __launch_bounds__(NTHREADS, 2) fwd_megakernel(Args a) {
    extern __shared__ __attribute__((aligned(16))) unsigned char lds_raw[];
    LAS unsigned char* lds = (LAS unsigned char*)lds_raw;
    cg::grid_group grid = cg::this_grid();
    unsigned char* ws = a.ws;
    const int lo = a.ph_lo, hi = a.ph_hi;
    volatile LAS unsigned* misc = (volatile LAS unsigned*)(lds + 132096);
    const int wave_s = __builtin_amdgcn_readfirstlane((int)threadIdx.x >> 6);
    if (a.coop == 2) grid.sync();
    if (wave_s == 0 && lane_id() < 2) misc[lane_id()] = 0u;
    __syncthreads();
    XcdBarrier bar; bar.bar = (unsigned*)(ws + WS_BAR); bar.x = 0; bar.st = nullptr; bar.wave = wave_s;
    if (a.coop) bar = xcd_barrier_post((unsigned*)(ws + WS_BAR), misc, wave_s);
#ifndef PH_MASK
#define PH_MASK 0xff
#endif
#define IN(k) (((PH_MASK >> (k)) & 1) && lo <= (k) && (k) < hi)
#define SEAM(k) do { if (a.coop && IN(k) && IN((k) + 1)) xcd_barrier(bar); } while (0)
    if (IN(0)) { for (int rep_ = 0; rep_ < REP_SMALL; ++rep_) { phase_prologue(a, lds, wave_s); __syncthreads(); } }
    SEAM(0);
    if (IN(1)) {
        pg8::Gemm g{(const pg8::bf16_t*)(ws + WS_XB), (const pg8::bf16_t*)(ws + WS_W0T), M_TOK, 4096, 1024}; pg8::StaticOrder S; S.init(M_TOK, 4096, gridDim.x, (int)blockIdx.x);
        pg8::Epi1 E{(const float*)(ws + WS_RSTD0), (pg8::bf16_t*)(ws + WS_QKV), (pg8::bf16_t*)(ws + WS_SG), (const float*)(ws + WS_GAINS), (const float*)(ws + WS_ROPE), (float*)(ws + WS_KMP)};
        _Pragma("unroll 1") for (int rep_ = 0; rep_ < REP_G1; ++rep_) pg8::gemm_phase<pg8::Epi1, pg8::StaticOrder, true, true>(lds, g, S, E, wave_s);
        for (int seq = blockIdx.x; seq < 64; seq += gridDim.x) cumsum_item((const float*)(ws + WS_LOGF), (float*)(ws + WS_CUM), (bf16*)(ws + WS_KX), seq, lds, wave_s);
    }
    SEAM(1);
    if (IN(3)) { attn_phase<0>(a, lds, wave_s, WS_MIX);
#if ATT_VAR >= 0
        attn_phase<ATT_VAR>(a, lds, wave_s, WS_END);
#endif
    }
    SEAM(3);
    if (IN(4)) {
        pg8::Gemm g{(const pg8::bf16_t*)(ws + WS_MIX), (const pg8::bf16_t*)(ws + WS_WO0T), M_TOK, 1024, 1024}; pg8::StaticOrder S; S.init(M_TOK, 1024, gridDim.x, (int)blockIdx.x);
        pg8::Epi2 E{a.in[0], a.out, (pg8::bf16_t*)(ws + WS_XB), (float*)(ws + WS_SSQP)};
        _Pragma("unroll 1") for (int rep_ = 0; rep_ < REP_G2; ++rep_) pg8::gemm_phase<pg8::Epi2, pg8::StaticOrder, true, true>(lds, g, S, E, wave_s);
    }
    SEAM(4);
    if (IN(5)) {
        pg8::Gemm g{(const pg8::bf16_t*)(ws + WS_XB), (const pg8::bf16_t*)(ws + WS_W1T), M_TOK, 3072, 1024}; pg8::StaticOrder S; S.init(M_TOK, 3072, gridDim.x, (int)blockIdx.x);
        pg8::Epi3 E{(const float*)(ws + WS_SSQP), (pg8::bf16_t*)(ws + WS_U), (pg8::bf16_t*)(ws + WS_SZ)};
        _Pragma("unroll 1") for (int rep_ = 0; rep_ < REP_G3; ++rep_) pg8::gemm_phase<pg8::Epi3, pg8::StaticOrder, true, true>(lds, g, S, E, wave_s);
    }
    SEAM(5);
    if (IN(6)) { for (int rep_ = 0; rep_ < REP_SMALL; ++rep_) conv_phase(a, lds, wave_s); }
    SEAM(6);
    if (IN(7)) {
        pg8::Gemm g{(const pg8::bf16_t*)(ws + WS_A2), (const pg8::bf16_t*)(ws + WS_WO1T), M_TOK, 1024, 1024}; pg8::StaticOrder S; S.init(M_TOK, 1024, gridDim.x, (int)blockIdx.x);
        pg8::Epi4 E{a.out, (const pg8::bf16_t*)(ws + WS_XB)};
        pg8::gemm_phase<pg8::Epi4, pg8::StaticOrder, true, true>(lds, g, S, E, wave_s);
    }
#undef IN
#undef SEAM
}

#ifndef MK_PER_PHASE
#define MK_PER_PHASE 0
#endif
extern "C" void kernel_launch(void* const* d_in, const int* in_sizes, int n_in, void* d_out, int out_size, void* d_ws, size_t ws_size, hipStream_t stream) {
    static int grid = 0;
    if (grid == 0) {
        if (n_in != 16 || out_size != M_TOK * DM || ws_size < WS_END + 64 * MiB) { fprintf(stderr, "kernel_launch: unexpected shapes (n_in %d out %d ws %zu)\n", n_in, out_size, ws_size); grid = -1; return; }
        int dev = 0, cus = 0, per_cu = 0;
        hipGetDevice(&dev); hipDeviceGetAttribute(&cus, hipDeviceAttributeMultiprocessorCount, dev);
        if (hipFuncSetAttribute((const void*)fwd_megakernel, hipFuncAttributeMaxDynamicSharedMemorySize, LDS_BYTES) != hipSuccess) { fprintf(stderr, "kernel_launch: hipFuncSetAttribute failed\n"); grid = -1; return; }
        if (hipOccupancyMaxActiveBlocksPerMultiprocessor(&per_cu, (const void*)fwd_megakernel, NTHREADS, LDS_BYTES) != hipSuccess || per_cu < 1) { fprintf(stderr, "kernel_launch: occupancy query says %d\n", per_cu); per_cu = 1; }
        (void)hipGetLastError();
        grid = cus * per_cu;
    }
    if (grid < 0) return;
    if (hipMemsetAsync((char*)d_ws + WS_BAR, 0, XCD_BAR_WORDS * 4, stream) != hipSuccess) { fprintf(stderr, "kernel_launch: memset failed\n"); return; }
    Args a{};
    for (int i = 0; i < 16; ++i) a.in[i] = (const float*)d_in[i];
    a.out = (float*)d_out; a.ws = (unsigned char*)d_ws;
#if MK_PER_PHASE
    for (int p = 0; p < 8; ++p) { a.ph_lo = p; a.ph_hi = p + 1; a.coop = 0; hipLaunchKernelGGL(fwd_megakernel, dim3(grid), dim3(NTHREADS), LDS_BYTES, stream, a); }
#else
    a.ph_lo = 0; a.ph_hi = 8; a.coop = 1;
    void* args[] = {&a};
    hipError_t e = hipLaunchCooperativeKernel((const void*)fwd_megakernel, dim3(grid), dim3(NTHREADS), args, LDS_BYTES, stream);
    if (e != hipSuccess) fprintf(stderr, "cooperative launch failed: %s (grid %d)\n", hipGetErrorString(e), grid);
#endif
}
```

```cpp
#include <hip/hip_runtime.h>
#include <hip/hip_cooperative_groups.h>
#include <cstdio>
#include <cstdint>
namespace cg = cooperative_groups;
namespace pg8 {
#define PG8_LAS __attribute__((address_space(3)))
typedef unsigned short bf16_t;
typedef short bf16x8 __attribute__((ext_vector_type(8)));
typedef float f32x4 __attribute__((ext_vector_type(4)));
typedef unsigned u32x4 __attribute__((ext_vector_type(4)));
constexpr int BM = 256, BK = 64, HALF = 128, HTB = HALF * BK * 2  , STAGE_BYTES = 8 * HTB, NXCD = 8, WGM = 8;

__host__ __device__ __forceinline__ int lds_byte(int r, int c) { const int st = (r >> 4) * 2 + (c >> 5), rr = r & 15, cc = c & 31, ob = rr * 64 + cc * 2; return st * 1024 + (ob ^ (((ob >> 9) & 1) << 5)); }
__host__ __device__ __forceinline__ void stage_rc(int b, int& R, int& C) { const int st = b / 1024, sb = b % 1024, swz = sb ^ (((sb >> 9) & 1) << 5); R = (st >> 1) * 16 + swz / 64; C = (st & 1) * 32 + (swz % 64) / 2; }
__host__ __device__ __forceinline__ int perm32(int rho) { const int n = rho >> 4, i = rho & 15; return 8 * (i >> 2) + 4 * n + (i & 3); }

struct Unit { int pm, pn; };
struct Gemm { const bf16_t* A; const bf16_t* Bt; int M, N, K; };

struct StaticOrder {
    int nM, nN, nwg, G, c;
    __host__ __device__ void init(int M, int N, int G_, int c_) { nM = M / BM; nN = N / BM; nwg = nM * nN; G = G_; c = c_; }
    __host__ __device__ bool next(int i, Unit& u) const {
        const long L = (long)i * G + c; if (L >= nwg) return false;
        int wgid = (int)L; { const int q = nwg / NXCD, r = nwg % NXCD, xcd = wgid % NXCD, off = wgid / NXCD; wgid = (xcd < r ? xcd * (q + 1) : r * (q + 1) + (xcd - r) * q) + off; }
        const int nig = WGM * nN, gid = wgid / nig, fm = gid * WGM, gsz = (nM - fm) < WGM ? (nM - fm) : WGM;
        u.pm = fm + ((wgid % nig) % gsz); u.pn = (wgid % nig) / gsz; return true;
    }
    __device__ __forceinline__ void a_ready(const Unit&) const {}
    __device__ __forceinline__ void done(const Unit&) const {}
};

__device__ __forceinline__ unsigned cvt_pk_bf16(float lo, float hi) { unsigned r; asm volatile("v_cvt_pk_bf16_f32 %0, %1, %2" : "=v"(r) : "v"(lo), "v"(hi)); return r; }
typedef float f32x2 __attribute__((ext_vector_type(2)));

constexpr float C2F = 0.125f * 1.4426950408889634f;
__device__ __forceinline__ float silu_f(float v) { return v * __builtin_amdgcn_rcpf(1.f + __expf(-v)); }
__device__ __forceinline__ u32x4 pack8(const float* v) { u32x4 w; w.x = cvt_pk_bf16(v[0], v[1]); w.y = cvt_pk_bf16(v[2], v[3]); w.z = cvt_pk_bf16(v[4], v[5]); w.w = cvt_pk_bf16(v[6], v[7]); return w; }

struct Epi1 {
    static constexpr bool PERM = true, AFTER_DRAIN = false;
    const float* rstd; bf16_t* qkv; bf16_t* sg; const float* gains; const float* rope; float* kmp;
    __device__ __forceinline__ void operator()(const f32x4 (&acc)[2][2][4][2], const Unit& u, int wr, int wc, int fr, int fq) const {
        const int pn = u.pn; const int row0 = u.pm * BM + wr * 64 + fr;
        float rsv[8];
#pragma unroll
        for (int i = 0; i < 8; ++i) rsv[i] = rstd[row0 + (i >> 2) * HALF + (i & 3) * 16];
        if (pn >= 12) {
            const int col0 = (pn - 12) * 256 + wc * 32 + 8 * fq;
#pragma unroll
            for (int ai = 0; ai < 2; ++ai)
#pragma unroll
                for (int m = 0; m < 4; ++m) {
                    const int r = row0 + ai * HALF + m * 16; const float rs = rsv[ai * 4 + m]; bf16_t* rowp = sg + (size_t)r * 1024 + col0;
#pragma unroll
                    for (int bj = 0; bj < 2; ++bj) { float v[8];
#pragma unroll
                        for (int n = 0; n < 2; ++n)
#pragma unroll
                            for (int e = 0; e < 4; ++e) v[4 * n + e] = silu_f(acc[ai][bj][m][n][e] * rs);
                        *(u32x4*)(rowp + bj * HALF) = pack8(v); }
                }
        } else {
            const int s = pn >> 1, head = 4 * (pn & 1) + wc;
            const bool isnorm = (s != 2) && (s != 5), isq = (s == 0) || (s == 3), isrope = (s == 3) || (s == 4);
            const float* gain = gains + 64 * ((s == 0) ? 0 : (s == 1) ? 1 : (s == 3) ? 2 : 3);
            float gn[2][8];
#pragma unroll
            for (int bj = 0; bj < 2; ++bj)
#pragma unroll
                for (int i = 0; i < 8; ++i) gn[bj][i] = isnorm ? gain[32 * bj + 8 * fq + i] * (isq ? C2F : 1.f) : 1.f;
            bf16_t* dst = qkv + (size_t)s * ((size_t)16 << 20);
            float csum[2][8];
#pragma unroll
            for (int bj = 0; bj < 2; ++bj)
#pragma unroll
                for (int i = 0; i < 8; ++i) csum[bj][i] = 0.f;
#pragma unroll
            for (int ai = 0; ai < 2; ++ai)
#pragma unroll
                for (int m = 0; m < 4; ++m) {
                    const int r = row0 + ai * HALF + m * 16; const float rs = rsv[ai * 4 + m];
                    float v[2][8]; float ss = 0.f;
#pragma unroll
                    for (int bj = 0; bj < 2; ++bj)
#pragma unroll
                        for (int n = 0; n < 2; ++n)
#pragma unroll
                            for (int e = 0; e < 4; ++e) { const float t_ = acc[ai][bj][m][n][e] * rs; v[bj][4 * n + e] = t_; ss += t_ * t_; }
                    const int t = r & 4095, b = r >> 12;
                    if (isnorm) {
                        ss += __shfl_xor(ss, 16); ss += __shfl_xor(ss, 32);
                        const float inv = __builtin_amdgcn_rsqf(ss * (1.0f / 64.0f) + 1e-6f);
#pragma unroll
                        for (int bj = 0; bj < 2; ++bj)
#pragma unroll
                            for (int i = 0; i < 8; ++i) v[bj][i] *= inv * gn[bj][i];
                        if (isrope) {
                            const f32x4* rp = (const f32x4*)(rope + t * 16);
                            f32x4 cs[4];
#pragma unroll
                            for (int k = 0; k < 4; ++k) cs[k] = rp[k];
#pragma unroll
                            for (int i = 0; i < 8; ++i) {
                                const float partner = __shfl_xor(v[0][i], 16);
                                const float c = cs[i >> 1][(i & 1) * 2], sn = cs[i >> 1][(i & 1) * 2 + 1];
                                const float rot = (fq == 0) ? (v[0][i] * c - partner * sn) : (v[0][i] * c + partner * sn);
                                v[0][i] = (fq < 2) ? rot : v[0][i];
                            }
                        }
                    }
                    bf16_t* p = dst + ((size_t)((b * 8 + head) * 4096 + t)) * 64 + 8 * fq;
                    *(u32x4*)(p) = pack8(v[0]); *(u32x4*)(p + 32) = pack8(v[1]);
                    if (s == 4) {
#pragma unroll
                        for (int bj = 0; bj < 2; ++bj)
#pragma unroll
                            for (int i = 0; i < 8; ++i) csum[bj][i] += v[bj][i];
                    }
                }
            if (s == 4) {
#pragma unroll
                for (int bj = 0; bj < 2; ++bj)
#pragma unroll
                    for (int i = 0; i < 8; ++i) { float c = csum[bj][i]; c += __shfl_xor(c, 1); c += __shfl_xor(c, 2); c += __shfl_xor(c, 4); c += __shfl_xor(c, 8); csum[bj][i] = c; }
                if (fr == 0) {
                    float* kp = kmp + ((size_t)wr * 64 * 16 + (size_t)((u.pm >> 4) * 8 + head) * 16 + (u.pm & 15)) * 64 + 8 * fq;
                    *(f32x4*)(kp) = (f32x4){csum[0][0], csum[0][1], csum[0][2], csum[0][3]}; *(f32x4*)(kp + 4) = (f32x4){csum[0][4], csum[0][5], csum[0][6], csum[0][7]};
                    *(f32x4*)(kp + 32) = (f32x4){csum[1][0], csum[1][1], csum[1][2], csum[1][3]}; *(f32x4*)(kp + 36) = (f32x4){csum[1][4], csum[1][5], csum[1][6], csum[1][7]};
                }
            }
        }
    }
};

struct Epi2 {
    static constexpr bool PERM = true, AFTER_DRAIN = false;
    const float* x; float* x1; bf16_t* x1b; float* ssqp;
    __device__ __forceinline__ void operator()(const f32x4 (&acc)[2][2][4][2], const Unit& u, int wr, int wc, int fr, int fq) const {
        const int row0 = u.pm * BM + wr * 64 + fr; const int col0 = u.pn * BM + wc * 32 + 8 * fq;
        float ssr[8];
#pragma unroll
        for (int ai = 0; ai < 2; ++ai) {
            f32x4 xv[4][2][2];
#pragma unroll
            for (int m = 0; m < 4; ++m)
#pragma unroll
                for (int bj = 0; bj < 2; ++bj) { const size_t off = (size_t)(row0 + ai * HALF + m * 16) * 1024 + col0 + bj * HALF; xv[m][bj][0] = *(const f32x4*)(x + off); xv[m][bj][1] = *(const f32x4*)(x + off + 4); }
#pragma unroll
            for (int m = 0; m < 4; ++m) {
                const int r = row0 + ai * HALF + m * 16; float ss = 0.f;
#pragma unroll
                for (int bj = 0; bj < 2; ++bj) {
                    const size_t off = (size_t)r * 1024 + col0 + bj * HALF;
                    const f32x4 va = xv[m][bj][0] + acc[ai][bj][m][0], vb = xv[m][bj][1] + acc[ai][bj][m][1];
                    float v[8] = {va[0], va[1], va[2], va[3], vb[0], vb[1], vb[2], vb[3]};
#pragma unroll
                    for (int i = 0; i < 8; ++i) ss += v[i] * v[i];
                    *(u32x4*)(x1b + off) = pack8(v);
                }
                ss += __shfl_xor(ss, 16); ss += __shfl_xor(ss, 32);
                ssr[ai * 4 + m] = ss;
            }
        }
        if (fq == 0) {
#pragma unroll
            for (int ai = 0; ai < 2; ++ai)
#pragma unroll
                for (int m = 0; m < 4; ++m) ssqp[(size_t)(row0 + ai * HALF + m * 16) * 16 + u.pn * 4 + wc] = ssr[ai * 4 + m];
        }
    }
};

struct Epi3 {
    static constexpr bool PERM = true, AFTER_DRAIN = false;
    const float* ssqp; bf16_t* U; bf16_t* SZ;
    __device__ __forceinline__ void operator()(const f32x4 (&acc)[2][2][4][2], const Unit& u, int wr, int wc, int fr, int fq) const {
        const int pn = u.pn; const int row0 = u.pm * BM + wr * 64 + fr;
#pragma unroll
        for (int ai = 0; ai < 2; ++ai) {
            float rsv[4];
#pragma unroll
            for (int m = 0; m < 4; ++m) {
                const f32x4* sp = (const f32x4*)(ssqp + (size_t)(row0 + ai * HALF + m * 16) * 16);
                const f32x4 s0 = sp[0], s1 = sp[1], s2 = sp[2], s3 = sp[3];
                const f32x4 st = (s0 + s1) + (s2 + s3);
                rsv[m] = __builtin_amdgcn_rsqf(((st[0] + st[1]) + (st[2] + st[3])) * (1.0f / 1024.0f) + 1e-6f); }
#pragma unroll
            for (int m = 0; m < 4; ++m) {
                const int r = row0 + ai * HALF + m * 16;
                const float rs = rsv[m];
                if (pn < 8) {
                    float v[8];
#pragma unroll
                    for (int n = 0; n < 2; ++n)
#pragma unroll
                        for (int e = 0; e < 4; ++e) { const float val = acc[ai][0][m][n][e] * rs, g = acc[ai][1][m][n][e] * rs; v[4 * n + e] = val * __builtin_amdgcn_rcpf(1.f + __expf(-g)); }
                    *(u32x4*)(U + (size_t)r * 1024 + pn * 128 + wc * 32 + 8 * fq) = pack8(v);
                } else {
#pragma unroll
                    for (int bj = 0; bj < 2; ++bj) { float v[8];
#pragma unroll
                        for (int n = 0; n < 2; ++n)
#pragma unroll
                            for (int e = 0; e < 4; ++e) v[4 * n + e] = silu_f(acc[ai][bj][m][n][e] * rs);
                        *(u32x4*)(SZ + (size_t)r * 1024 + (pn - 8) * 256 + bj * HALF + wc * 32 + 8 * fq) = pack8(v); }
                }
            }
        }
    }
};

struct Epi4 {
    static constexpr bool PERM = true, AFTER_DRAIN = false;
    float* out; const bf16_t* x1b;
    __device__ __forceinline__ void operator()(const f32x4 (&acc)[2][2][4][2], const Unit& u, int wr, int wc, int fr, int fq) const {
        const int row0 = u.pm * BM + wr * 64 + fr; const int col0 = u.pn * BM + wc * 32 + 8 * fq;
#pragma unroll
        for (int ai = 0; ai < 2; ++ai) {
            u32x4 xw[4][2];
#pragma unroll
            for (int m = 0; m < 4; ++m)
#pragma unroll
                for (int bj = 0; bj < 2; ++bj) xw[m][bj] = *(const u32x4*)(x1b + (size_t)(row0 + ai * HALF + m * 16) * 1024 + col0 + bj * HALF);
#pragma unroll
            for (int m = 0; m < 4; ++m)
#pragma unroll
                for (int bj = 0; bj < 2; ++bj) {
                    float* p = out + (size_t)(row0 + ai * HALF + m * 16) * 1024 + col0 + bj * HALF; const u32x4 w = xw[m][bj];
                    const f32x4 xa = {__uint_as_float(w.x << 16), __uint_as_float(w.x & 0xffff0000u), __uint_as_float(w.y << 16), __uint_as_float(w.y & 0xffff0000u)};
                    const f32x4 xb = {__uint_as_float(w.z << 16), __uint_as_float(w.z & 0xffff0000u), __uint_as_float(w.w << 16), __uint_as_float(w.w & 0xffff0000u)};
                    *(f32x4*)(p) = xa + acc[ai][bj][m][0]; *(f32x4*)(p + 4) = xb + acc[ai][bj][m][1];
                }
        }
    }
};

template <class Epi, class Sched, bool ALIGN_EPI = false, bool SP2 = false>
__device__ __forceinline__ void gemm_phase(PG8_LAS unsigned char* lds, const Gemm g, const Sched& S, const Epi& E, int wave_s) {
    const int lane = __builtin_amdgcn_mbcnt_hi(~0u, __builtin_amdgcn_mbcnt_lo(~0u, 0u)), wid = wave_s, tid = wave_s * 64 + lane, wr = wid >> 2, wc = wid & 3, fr = lane & 15, fq = lane >> 4;
    const int K = g.K, nt = K / BK;
    unsigned voffA[2], voffB[2];
#pragma unroll
    for (int i = 0; i < 2; ++i) { int R, C; stage_rc(tid * 16 + i * 8192, R, C); const int Rb = Epi::PERM ? ((R & ~31) + perm32(R & 31)) : R;
        voffA[i] = (unsigned)(R * K + C) * 2u; voffB[i] = (unsigned)(Rb * K + C) * 2u; }
    const size_t kstep = (size_t)(BK * 2);
    const size_t hstep = (size_t)HALF * K * 2;
    const size_t tstep = 2 * hstep;
    const unsigned ldsw = (unsigned)wid * 1024u;
    const int aoff = lds_byte(wr * 64 + fr, fq * 8), boff = lds_byte(wc * 32 + fr, fq * 8);
#define PG8_SA(b, h) (((b) * 2 + (h)) * HTB)
#define PG8_SB(b, h) ((4 + (b) * 2 + (h)) * HTB)
#define PG8_STAGE(bufoff, gbase, voff) do { _Pragma("unroll") for (int _i = 0; _i < 2; ++_i) \
        __builtin_amdgcn_global_load_lds((const unsigned*)((const char*)(gbase) + (voff)[_i]), (PG8_LAS unsigned*)(lds + (bufoff) + ldsw + _i * 8192), 16, 0, 0); } while (0)
#define PG8_LDA(dst, b, h) do { _Pragma("unroll") for (int m = 0; m < 4; ++m) _Pragma("unroll") for (int k = 0; k < 2; ++k) dst[m][k] = *(const PG8_LAS bf16x8*)(lds + PG8_SA(b, h) + aoff + m * 2048 + k * 1024); } while (0)
#define PG8_LDB(dst, b, h) do { _Pragma("unroll") for (int n = 0; n < 2; ++n) _Pragma("unroll") for (int k = 0; k < 2; ++k) dst[n][k] = *(const PG8_LAS bf16x8*)(lds + PG8_SB(b, h) + boff + n * 2048 + k * 1024); } while (0)
#define PG8_MMA(ai, bj, At, Bt) do { __builtin_amdgcn_s_setprio(1); _Pragma("unroll") for (int m = 0; m < 4; ++m) _Pragma("unroll") for (int n = 0; n < 2; ++n) _Pragma("unroll") for (int k = 0; k < 2; ++k) \
        acc[ai][bj][m][n] = __builtin_amdgcn_mfma_f32_16x16x32_bf16(Bt[n][k], At[m][k], acc[ai][bj][m][n], 0, 0, 0); __builtin_amdgcn_s_setprio(0); } while (0)
#define PG8_WAIT_V(n) asm volatile("s_waitcnt vmcnt(" #n ")" ::: "memory")
#define PG8_WAIT_L(n) asm volatile("s_waitcnt lgkmcnt(" #n ")" ::: "memory")
#define PG8_BAR __builtin_amdgcn_s_barrier()
#define PG8_SCHED __builtin_amdgcn_sched_barrier(0)
    Unit cur, nxt; int ui = 0;
    if (!S.next(0, cur)) return;
    f32x4 acc[2][2][4][2];
#pragma unroll
    for (int a = 0; a < 2; ++a)
#pragma unroll
        for (int b = 0; b < 2; ++b)
#pragma unroll
            for (int m = 0; m < 4; ++m)
#pragma unroll
                for (int n = 0; n < 2; ++n) acc[a][b][m][n] = (f32x4){0.f, 0.f, 0.f, 0.f};
    bf16x8 At[4][2], B0[2][2], B1[2][2];
    const char* cA = (const char*)g.A + (size_t)cur.pm * tstep; const char* cB = (const char*)g.Bt + (size_t)cur.pn * tstep;
    S.a_ready(cur);
    if constexpr (SP2) {
        PG8_STAGE(PG8_SB(0, 0), cB, voffB); PG8_STAGE(PG8_SB(0, 1), cB + hstep, voffB); PG8_STAGE(PG8_SA(0, 0), cA, voffA); PG8_STAGE(PG8_SA(0, 1), cA + hstep, voffA);
        if (wr == 1) PG8_BAR;
        PG8_WAIT_V(2); PG8_BAR;
        PG8_STAGE(PG8_SB(1, 0), cB + kstep, voffB); PG8_STAGE(PG8_SA(1, 0), cA + kstep, voffA); PG8_STAGE(PG8_SB(1, 1), cB + hstep + kstep, voffB);
        PG8_WAIT_V(6); PG8_BAR;
    } else {
        PG8_STAGE(PG8_SB(0, 0), cB, voffB); PG8_STAGE(PG8_SA(0, 0), cA, voffA); PG8_STAGE(PG8_SB(0, 1), cB + hstep, voffB); PG8_STAGE(PG8_SA(0, 1), cA + hstep, voffA);
        if (wr == 1) PG8_BAR;
        PG8_WAIT_V(4); PG8_BAR;
        PG8_STAGE(PG8_SB(1, 0), cB + kstep, voffB); PG8_STAGE(PG8_SA(1, 0), cA + kstep, voffA); PG8_STAGE(PG8_SB(1, 1), cB + hstep + kstep, voffB);
        PG8_WAIT_V(6); PG8_BAR;
    }
    for (;;) {
        const bool has_next = S.next(ui + 1, nxt);
        const char* nA = has_next ? (const char*)g.A + (size_t)nxt.pm * tstep : cA; const char* nB = has_next ? (const char*)g.Bt + (size_t)nxt.pn * tstep : cB;
        for (int t = 0; t < nt; t += 2) {
            const bool last = (t == nt - 2);
            const char* a1 = cA + (size_t)(t + 1) * kstep;
            const char* a2 = last ? nA : cA + (size_t)(t + 2) * kstep; const char* b2 = last ? nB : cB + (size_t)(t + 2) * kstep;
            const char* a3 = a2 + kstep; const char* b3 = b2 + kstep;
            if (last && has_next) S.a_ready(nxt);
            if constexpr (SP2) {
            PG8_LDB(B0, 0, 0); PG8_LDB(B1, 0, 1); PG8_SCHED; PG8_LDA(At, 0, 0); PG8_STAGE(PG8_SA(1, 1), a1 + hstep, voffA);
            PG8_WAIT_V(8); PG8_WAIT_L(0); PG8_BAR; PG8_MMA(0, 0, At, B0); PG8_MMA(0, 1, At, B1); PG8_BAR; PG8_SCHED;
            PG8_LDA(At, 0, 1); PG8_STAGE(PG8_SB(0, 0), b2, voffB); PG8_STAGE(PG8_SB(0, 1), b2 + hstep, voffB); PG8_STAGE(PG8_SA(0, 0), a2, voffA);
            PG8_WAIT_V(8); PG8_WAIT_L(0); PG8_BAR; PG8_MMA(1, 0, At, B0); PG8_MMA(1, 1, At, B1); PG8_BAR; PG8_SCHED;
            PG8_LDB(B0, 1, 0); PG8_LDB(B1, 1, 1); PG8_SCHED; PG8_LDA(At, 1, 0); PG8_STAGE(PG8_SA(0, 1), a2 + hstep, voffA);
            PG8_WAIT_V(8); PG8_WAIT_L(0); PG8_BAR; PG8_MMA(0, 0, At, B0); PG8_MMA(0, 1, At, B1); PG8_BAR; PG8_SCHED;
            PG8_LDA(At, 1, 1); PG8_STAGE(PG8_SB(1, 0), b3, voffB); PG8_STAGE(PG8_SB(1, 1), b3 + hstep, voffB); PG8_STAGE(PG8_SA(1, 0), a3, voffA);
            PG8_WAIT_V(8); PG8_WAIT_L(0); PG8_BAR; PG8_MMA(1, 0, At, B0); PG8_MMA(1, 1, At, B1); PG8_BAR; PG8_SCHED;
            } else {
            PG8_LDB(B0, 0, 0); PG8_SCHED; PG8_LDA(At, 0, 0); PG8_STAGE(PG8_SA(1, 1), a1 + hstep, voffA);
            PG8_WAIT_L(8); PG8_BAR; PG8_WAIT_L(0); PG8_MMA(0, 0, At, B0); PG8_BAR; PG8_SCHED;
            PG8_LDB(B1, 0, 1); PG8_STAGE(PG8_SB(0, 0), b2, voffB);
            PG8_BAR; PG8_WAIT_L(0); PG8_MMA(0, 1, At, B1); PG8_BAR;
            PG8_LDA(At, 0, 1); PG8_STAGE(PG8_SA(0, 0), a2, voffA);
            PG8_BAR; PG8_WAIT_L(0); PG8_MMA(1, 0, At, B0); PG8_BAR; PG8_SCHED;
            PG8_STAGE(PG8_SB(0, 1), b2 + hstep, voffB);
            PG8_WAIT_V(6); PG8_BAR; PG8_MMA(1, 1, At, B1); PG8_BAR;
            PG8_LDB(B0, 1, 0); PG8_SCHED; PG8_LDA(At, 1, 0); PG8_STAGE(PG8_SA(0, 1), a2 + hstep, voffA);
            PG8_WAIT_L(8); PG8_BAR; PG8_WAIT_L(0); PG8_MMA(0, 0, At, B0); PG8_BAR; PG8_SCHED;
            PG8_LDB(B1, 1, 1); PG8_STAGE(PG8_SB(1, 0), b3, voffB);
            PG8_BAR; PG8_WAIT_L(0); PG8_MMA(0, 1, At, B1); PG8_BAR;
            PG8_LDA(At, 1, 1); PG8_STAGE(PG8_SA(1, 0), a3, voffA);
            PG8_BAR; PG8_WAIT_L(0); PG8_MMA(1, 0, At, B0); PG8_BAR; PG8_SCHED;
            PG8_STAGE(PG8_SB(1, 1), b3 + hstep, voffB);
            PG8_WAIT_V(6); PG8_BAR; PG8_MMA(1, 1, At, B1); PG8_BAR;
            }
        }
        if constexpr (ALIGN_EPI) { if (wr == 0) PG8_BAR; }
        if constexpr (!Epi::AFTER_DRAIN) { E(acc, cur, wr, wc, fr, fq); S.done(cur); }
        if (!has_next) break;
#pragma unroll
        for (int a = 0; a < 2; ++a)
#pragma unroll
            for (int b = 0; b < 2; ++b)
#pragma unroll
                for (int m = 0; m < 4; ++m)
#pragma unroll
                    for (int n = 0; n < 2; ++n) acc[a][b][m][n] = (f32x4){0.f, 0.f, 0.f, 0.f};
        cur = nxt; cA = nA; cB = nB; ++ui;
        if constexpr (ALIGN_EPI) { if (wr == 1) PG8_BAR; }
    }
    PG8_WAIT_V(0);
    if constexpr (!ALIGN_EPI) { if (wr == 0) PG8_BAR; }
    PG8_BAR;
    if constexpr (Epi::AFTER_DRAIN) { E.fused(acc, cur, wr, wc, fr, fq, lds, wid, lane); S.done(cur); }
#undef PG8_SA
#undef PG8_SB
#undef PG8_STAGE
#undef PG8_LDA
#undef PG8_LDB
#undef PG8_MMA
#undef PG8_WAIT_V
#undef PG8_WAIT_L
#undef PG8_BAR
#undef PG8_SCHED
}
}

#ifndef REP_G1
#define REP_G1 1
#endif
#ifndef REP_G2
#define REP_G2 1
#endif
#ifndef REP_G3
#define REP_G3 1
#endif
#ifndef ATT_VAR
#define ATT_VAR -1
#endif
#ifndef REP_ATTN
#define REP_ATTN 1
#endif
#ifndef REP_SMALL
#define REP_SMALL 1
#endif
constexpr int NB = 8, SEQ = 4096, DM = 1024, NH = 8, HD = 64, M_TOK = NB * SEQ;
constexpr int EVEN_W = 4104, FLOG_COL = 1536, MOBA_COL = 1544, GATE_COL = 3080;
constexpr int NWAVES = 8, NTHREADS = 512;
constexpr int LDS_BYTES = 147456;

constexpr size_t MiB = (size_t)1 << 20;
constexpr size_t WS_W0T = 0, WS_WO0T = 8 * MiB, WS_W1T = 10 * MiB, WS_WO1T = 16 * MiB;
constexpr size_t WS_RSTD0 = 18 * MiB, WS_LOGF = 19 * MiB, WS_CUM = 20 * MiB, WS_KMEAN = 21 * MiB, WS_GAINS = 21 * MiB + 256 * 1024, WS_ROPE = 21 * MiB + 512 * 1024, WS_SSQP = 22 * MiB, WS_BAR = 24 * MiB, WS_KMP = 25 * MiB, WS_KX = 26 * MiB;
constexpr size_t WS_XB = 32 * MiB;
constexpr size_t WS_QKV = 96 * MiB;
constexpr size_t WS_SG = 288 * MiB, WS_MIX = 352 * MiB, WS_END = 416 * MiB;
constexpr size_t WS_U = 96 * MiB, WS_SZ = 160 * MiB, WS_A2 = 224 * MiB;

#define LAS __attribute__((address_space(3)))
typedef unsigned short bf16;
typedef float f32x4 __attribute__((ext_vector_type(4)));
typedef float f32x2 __attribute__((ext_vector_type(2)));
typedef float f32x16 __attribute__((ext_vector_type(16)));
typedef short bf16x8 __attribute__((ext_vector_type(8)));
typedef short s16x4 __attribute__((ext_vector_type(4)));
typedef unsigned u32x4 __attribute__((ext_vector_type(4)));
typedef unsigned u32x2 __attribute__((ext_vector_type(2)));
typedef __bf16 bf16x2_t __attribute__((ext_vector_type(2)));

__device__ __forceinline__ unsigned cvtpk(float lo, float hi) { f32x2 v = {lo, hi}; bf16x2_t b = __builtin_convertvector(v, bf16x2_t); return __builtin_bit_cast(unsigned, b); }
__device__ __forceinline__ float bflo(unsigned w) { return __uint_as_float(w << 16); }
__device__ __forceinline__ float bfhi(unsigned w) { return __uint_as_float(w & 0xffff0000u); }
__device__ __forceinline__ float dpp_add(float v, const int ctrl_tag) {
    int r;
    if (ctrl_tag == 0) r = __builtin_amdgcn_update_dpp(0, __builtin_bit_cast(int, v), 0xB1, 0xf, 0xf, false);
    else if (ctrl_tag == 1) r = __builtin_amdgcn_update_dpp(0, __builtin_bit_cast(int, v), 0x4E, 0xf, 0xf, false);
    else if (ctrl_tag == 2) r = __builtin_amdgcn_update_dpp(0, __builtin_bit_cast(int, v), 0x141, 0xf, 0xf, false);
    else r = __builtin_amdgcn_update_dpp(0, __builtin_bit_cast(int, v), 0x140, 0xf, 0xf, false);
    return v + __builtin_bit_cast(float, r);
}
__device__ __forceinline__ float row_sum16(float v) { v = dpp_add(v, 0); v = dpp_add(v, 1); v = dpp_add(v, 2); v = dpp_add(v, 3); return v; }
__device__ __forceinline__ float wave_sum(float v) {
    v = dpp_add(v, 0); v = dpp_add(v, 1); v = dpp_add(v, 2); v = dpp_add(v, 3);
    v += __shfl_xor(v, 16); v += __shfl_xor(v, 32);
    return v;
}
__device__ __forceinline__ int crow(int r, int hi) { return (r & 3) + 8 * (r >> 2) + 4 * hi; }

__device__ __forceinline__ int lane_id() { return (int)(__builtin_amdgcn_mbcnt_hi(~0u, __builtin_amdgcn_mbcnt_lo(~0u, 0u)) & 63u); }
#define XB_TMO      128
#define XB_XCNT(j)  (256  + 64 * (j))
#define XB_XSUB(j)  (1280 + 64 * (j))
#define XB_XGEN(j)  (2304 + 64 * (j))
#define XB_TOP      3328
#define XB_TOPGEN   3392
#define XCD_BAR_WORDS 3456
#define XB_SPIN_CAP (1u << 18)

__device__ __forceinline__ unsigned xb_ld(unsigned* p)              { return __hip_atomic_load(p, __ATOMIC_RELAXED, __HIP_MEMORY_SCOPE_AGENT); }
__device__ __forceinline__ unsigned xb_add(unsigned* p, unsigned v) { return __hip_atomic_fetch_add(p, v, __ATOMIC_RELAXED, __HIP_MEMORY_SCOPE_AGENT); }
__device__ __forceinline__ unsigned xb_xcc_id() { return (unsigned)__builtin_amdgcn_s_getreg((3 << 11) | 20) & 0xFu; }
#define XB_SPIN(cond, bar) do { unsigned _sp = 0; while (cond) { __builtin_amdgcn_s_sleep(1); \
    if ((++_sp & 255u) == 0u) { if (xb_ld(&(bar)[XB_TMO])) break; if (_sp > XB_SPIN_CAP) { atomicAdd(&(bar)[XB_TMO], 1u); break; } } } } while (0)

struct XcdBarrier {
    unsigned* bar; unsigned x; int wave;
    volatile LAS unsigned* st;
};

__device__ __forceinline__ XcdBarrier xcd_barrier_post(unsigned* bar, volatile LAS unsigned* st, int wave) {
    XcdBarrier b; b.bar = bar; b.x = xb_xcc_id(); b.st = st; b.wave = wave;
    if (wave == 0 && lane_id() == 0) (void)xb_add(&bar[XB_XCNT(b.x)], 1u);
    return b;
}
__device__ __forceinline__ void xcd_barrier_complete(unsigned* bar, unsigned x, unsigned& nloc, unsigned& nx) {
    const unsigned G = gridDim.x * gridDim.y * gridDim.z;
    unsigned sum, cnt, mine, sp = 0u;
    for (;;) {
        sum = 0u; cnt = 0u; mine = 0u;
#pragma unroll
        for (unsigned j = 0; j < 16; ++j) { const unsigned c = xb_ld(&bar[XB_XCNT(j)]); sum += c; cnt += (c > 0u) ? 1u : 0u; mine = (j == x) ? c : mine; }
        if (sum == G) break;
        __builtin_amdgcn_s_sleep(1);
        if ((++sp & 255u) == 0u) { if (xb_ld(&bar[XB_TMO])) break; if (sp > XB_SPIN_CAP) { atomicAdd(&bar[XB_TMO], 1u); break; } }
    }
    nloc = mine > 0u ? mine : 1u; nx = cnt > 0u ? cnt : 1u;
}

__device__ __forceinline__ void xcd_barrier(const XcdBarrier& b) {
    asm volatile("s_waitcnt vmcnt(0)" ::: "memory");
    __syncthreads();
    if (b.wave == 0 && lane_id() == 0) {
        unsigned* bar = b.bar;
        __builtin_amdgcn_s_waitcnt(0);
        unsigned nloc = b.st[0], nx = b.st[1];
        if (nloc == 0u) { xcd_barrier_complete(bar, b.x, nloc, nx); b.st[0] = nloc; b.st[1] = nx; }
        const unsigned old = xb_add(&bar[XB_XSUB(b.x)], 1u);
        const unsigned gen = old / nloc;
        if (old + 1u == (gen + 1u) * nloc) {
            __builtin_amdgcn_fence(__ATOMIC_RELEASE, "agent");
            asm volatile("s_waitcnt vmcnt(0)" ::: "memory");
            const unsigned og = xb_add(&bar[XB_TOP], 1u);
            const unsigned tg = og / nx;
            if (og + 1u == (tg + 1u) * nx) xb_add(&bar[XB_TOPGEN], 1u);
            else XB_SPIN(xb_ld(&bar[XB_TOPGEN]) == tg, bar);
            __builtin_amdgcn_fence(__ATOMIC_ACQUIRE, "agent");
            xb_add(&bar[XB_XGEN(b.x)], 1u);
            asm volatile("s_waitcnt vmcnt(0)" ::: "memory");
        } else {
            XB_SPIN(xb_ld(&bar[XB_XGEN(b.x)]) == gen, bar);
            __builtin_amdgcn_fence(__ATOMIC_ACQUIRE, "agent");
            asm volatile("s_waitcnt vmcnt(0)" ::: "memory");
        }
    }
    __syncthreads();
}

struct Args { const float* in[16]; float* out; unsigned char* ws; int ph_lo, ph_hi, coop, pad; };

__device__ __forceinline__ void transpose_item(const float* W, int K, int Nsrc, const float* kscale, bf16* WT, LAS float* scr, int k0, int n0, int src0, int lane) {
    float wv[32];
#pragma unroll
    for (int i = 0; i < 32; ++i) { const int kk = 2 * i + (lane >> 5); wv[i] = W[(size_t)(k0 + kk) * Nsrc + src0 + (lane & 31)]; }
#pragma unroll
    for (int i = 0; i < 32; ++i) { const int kk = 2 * i + (lane >> 5); float w = wv[i]; if (kscale) w *= kscale[k0 + kk]; scr[kk * 33 + (lane & 31)] = w; }
    asm volatile("s_waitcnt lgkmcnt(0)" ::: "memory");
    const int c = lane & 7;
#pragma unroll
    for (int j = 0; j < 4; ++j) { const int n = (lane >> 3) + 8 * j; const LAS float* s = scr + (8 * c) * 33 + n;
        u32x4 o; o.x = cvtpk(s[0 * 33], s[1 * 33]); o.y = cvtpk(s[2 * 33], s[3 * 33]); o.z = cvtpk(s[4 * 33], s[5 * 33]); o.w = cvtpk(s[6 * 33], s[7 * 33]);
        *(u32x4*)(WT + (size_t)(n0 + n) * K + k0 + 8 * c) = o; }
    asm volatile("s_waitcnt lgkmcnt(0)" ::: "memory");
}
__device__ __forceinline__ int src_col_l0(int np) {
    const int pn = np >> 8, cp = np & 255;
    if (pn >= 12) return GATE_COL + (np - 3072);
    const int s = pn >> 1, bj = cp >> 7, wc = (cp >> 5) & 3, j = cp & 31, head = 4 * (pn & 1) + wc, d = 32 * bj + j;
    const int base = (s < 3) ? s * 512 : MOBA_COL + (s - 3) * 512;
    return base + head * 64 + d;
}
__device__ __forceinline__ int src_col_l1(int np) {
    const int pn = np >> 8, cp = np & 255;
    if (pn >= 8) return 2048 + (np - 2048);
    return ((cp >> 7) ? 1024 : 0) + pn * 128 + (cp & 127);
}

__device__ __forceinline__ void phase_prologue(const Args& a, LAS unsigned char* lds, int wave_s) {
    const int lane = lane_id(), wave = wave_s, tid = wave_s * 64 + lane;
    const int G = gridDim.x, gw = blockIdx.x * NWAVES + wave, NGW = G * NWAVES;
    unsigned char* ws = a.ws;
    const float* x = a.in[0]; const float* l0_norm = a.in[1]; const float* l0_w_in = a.in[2]; const float* l0_b_f = a.in[3];
    const float* l0_w_out = a.in[8]; const float* l1_norm = a.in[9]; const float* l1_w_in = a.in[10]; const float* l1_w_out = a.in[15];
    if (blockIdx.x == 0 && tid < 256) { const int k = tid >> 6; const float* src = (k == 0) ? a.in[4] : (k == 1) ? a.in[5] : (k == 2) ? a.in[6] : a.in[7]; ((float*)(ws + WS_GAINS))[tid] = src[tid & 63]; }
    LAS float* wfl = (LAS float*)(lds + 73728);
    {   float wa[16], wb[16];
#pragma unroll
        for (int j = 0; j < 16; ++j) { const int i = tid + j * NTHREADS, k = i >> 3, h = i & 7; wa[j] = l0_w_in[(size_t)k * EVEN_W + FLOG_COL + h]; wb[j] = l0_norm[k]; }
#pragma unroll
        for (int j = 0; j < 16; ++j) wfl[tid + j * NTHREADS] = wa[j] * wb[j]; }
    LAS float* scr = (LAS float*)(lds + wave * 8448);
    constexpr int I0 = 16 * 128;
    for (int it = gw; it < I0; it += NGW) { const int kb = it / 128, nb = it % 128; transpose_item(l0_w_in, 1024, EVEN_W, l0_norm, (bf16*)(ws + WS_W0T), scr, 64 * kb, 32 * nb, src_col_l0(32 * nb), lane); }
    { float* rope = (float*)(ws + WS_ROPE);
      for (int i = blockIdx.x * NTHREADS + tid; i < SEQ * 8; i += G * NTHREADS) {
          const int pos = i >> 3, k = i & 7;
          const float inv_freq = exp2f(-(float)k * (18.931568569324174f / 8.0f));
          const float ang = (float)pos * inv_freq;
          const double rev = (double)ang * 0.15915494309189535;
          const float fr = (float)(rev - floor(rev));
          rope[2 * i] = __builtin_amdgcn_cosf(fr); rope[2 * i + 1] = __builtin_amdgcn_sinf(fr);
      } }
    __syncthreads();
    float* rstd0 = (float*)(ws + WS_RSTD0); float* logf = (float*)(ws + WS_LOGF); bf16* xb = (bf16*)(ws + WS_XB);
    f32x4 nv[4];
    if (gw < M_TOK) { const f32x4* xr0 = (const f32x4*)(x + (size_t)gw * DM) + lane;
#pragma unroll
        for (int j = 0; j < 4; ++j) nv[j] = xr0[64 * j]; }
    for (int m = gw; m < M_TOK; m += NGW) {
        f32x4 v[4]; float s = 0.f;
#pragma unroll
        for (int j = 0; j < 4; ++j) v[j] = nv[j];
        if (m + NGW < M_TOK) { const f32x4* xr = (const f32x4*)(x + (size_t)(m + NGW) * DM) + lane;
#pragma unroll
            for (int j = 0; j < 4; ++j) nv[j] = xr[64 * j]; }
#pragma unroll
        for (int j = 0; j < 4; ++j) s += (v[j].x * v[j].x + v[j].y * v[j].y) + (v[j].z * v[j].z + v[j].w * v[j].w);
        const float rstd = 1.0f / sqrtf(wave_sum(s) * (1.0f / DM) + 1e-6f);
        u32x2* o8 = (u32x2*)(xb + (size_t)m * DM) + lane;
        float fl[8];
#pragma unroll
        for (int h = 0; h < 8; ++h) fl[h] = 0.f;
#pragma unroll
        for (int j = 0; j < 4; ++j) {
            u32x2 pk; pk.x = cvtpk(v[j].x, v[j].y); pk.y = cvtpk(v[j].z, v[j].w); o8[64 * j] = pk;
#pragma unroll
            for (int e = 0; e < 4; ++e) {
                const LAS f32x4* wp = (const LAS f32x4*)(wfl + (256 * j + 4 * lane + e) * 8);
                const f32x4 w0 = wp[0], w1 = wp[1]; const float xv = v[j][e];
                fl[0] += xv * w0.x; fl[1] += xv * w0.y; fl[2] += xv * w0.z; fl[3] += xv * w0.w;
                fl[4] += xv * w1.x; fl[5] += xv * w1.y; fl[6] += xv * w1.z; fl[7] += xv * w1.w;
            }
        }
        float mine = 0.f;
#pragma unroll
        for (int h = 0; h < 8; ++h) { const float t_ = row_sum16(fl[h]); if ((lane & 15) == h) mine = t_; }
        mine += __shfl_xor(mine, 16); mine += __shfl_xor(mine, 32);
        if (lane == 0) rstd0[m] = rstd;
        if (lane < 8) {
            const float f = mine * rstd + l0_b_f[lane];
            const float ls = fminf(f, 0.f) - log1pf(__expf(-fabsf(f)));
            logf[((size_t)((m >> 12) * 8 + lane)) * SEQ + (m & 4095)] = ls;
        }
    }
}

__device__ __forceinline__ void late_weights(const Args& a, LAS unsigned char* lds, int wave_s, int gw0, int ngw) {
    const int lane = lane_id(); unsigned char* ws = a.ws;
    const float* l0_w_out = a.in[8]; const float* l1_norm = a.in[9]; const float* l1_w_in = a.in[10]; const float* l1_w_out = a.in[15];
    LAS float* scr = (LAS float*)(lds + wave_s * 8448);
    constexpr int I1 = 16 * 32, I2 = 16 * 96, I3 = 16 * 32;
    for (int it = gw0; it < I1 + I2 + I3; it += ngw) {
        int r = it;
        if (r < I1) { const int kb = r / 32, nb = r % 32; transpose_item(l0_w_out, 1024, 1024, nullptr, (bf16*)(ws + WS_WO0T), scr, 64 * kb, 32 * nb, 32 * nb, lane); continue; } r -= I1;
        if (r < I2) { const int kb = r / 96, nb = r % 96; transpose_item(l1_w_in, 1024, 3072, l1_norm, (bf16*)(ws + WS_W1T), scr, 64 * kb, 32 * nb, src_col_l1(32 * nb), lane); continue; } r -= I2;
        { const int kb = r / 32, nb = r % 32; transpose_item(l1_w_out, 1024, 1024, nullptr, (bf16*)(ws + WS_WO1T), scr, 64 * kb, 32 * nb, 32 * nb, lane); }
    }
}

__device__ __forceinline__ void cumsum_item(const float* logf, float* cum2, bf16* kx, int seq, LAS unsigned char* lds, int wave_s) {
    const int lane = lane_id(), wave = wave_s, tid = wave_s * 64 + lane;
    const f32x4* p = (const f32x4*)(logf + (size_t)seq * SEQ + tid * 8);
    const f32x4 a = p[0], b = p[1];
    float v[8] = {a.x, a.y, a.z, a.w, b.x, b.y, b.z, b.w};
#pragma unroll
    for (int i = 1; i < 8; ++i) v[i] += v[i - 1];
    float sc = v[7];
#pragma unroll
    for (int o = 1; o < 64; o <<= 1) { const float y = __shfl_up(sc, o); if (lane >= o) sc += y; }
    LAS float* wt = (LAS float*)lds;
    __syncthreads();
    if (lane == 63) wt[wave] = sc;
    __syncthreads();
    float off = sc - v[7];
    for (int w = 0; w < wave; ++w) off += wt[w];
    constexpr float L2E = 1.4426950408889634f;
    f32x4 o0 = {(v[0] + off) * L2E, (v[1] + off) * L2E, (v[2] + off) * L2E, (v[3] + off) * L2E}, o1 = {(v[4] + off) * L2E, (v[5] + off) * L2E, (v[6] + off) * L2E, (v[7] + off) * L2E};
    {
        u32x4* kxp = (u32x4*)(kx + ((size_t)seq * SEQ + tid * 8) * 8);
#pragma unroll
        for (int i = 0; i < 8; ++i) { const float nc = -((v[i] + off) * L2E);
            const unsigned h = cvtpk(nc, 0.f) & 0xffffu; const float r1 = nc - __uint_as_float(h << 16);
            const unsigned m = cvtpk(r1, 0.f) & 0xffffu; const float r2 = r1 - __uint_as_float(m << 16);
            const unsigned l = cvtpk(r2, 0.f) & 0xffffu;
            kxp[i] = (u32x4){h | (m << 16), l | 0x3F800000u, 0x3F803F80u, 0u}; } }
    f32x4* q = (f32x4*)(cum2 + (size_t)seq * SEQ + tid * 8); q[0] = o0; q[1] = o1;
    __syncthreads();
}

__device__ __forceinline__ void kmean_phase(const bf16* KM, float* kmean, LAS unsigned char* lds, int wave_s) {
    const int tid = wave_s * 64 + lane_id(), row = tid >> 3, ch = tid & 7;
    LAS float* red = (LAS float*)lds;
    for (int item = blockIdx.x; item < 64 * 16; item += gridDim.x) {
        const bf16* kp = KM + ((size_t)(item >> 4) * SEQ + (item & 15) * 256) * 64;
        float acc[8];
#pragma unroll
        for (int j = 0; j < 8; ++j) acc[j] = 0.f;
#pragma unroll
        for (int i = 0; i < 4; ++i) { const u32x4 v = *(const u32x4*)(kp + (size_t)(row + 64 * i) * 64 + ch * 8);
            acc[0] += bflo(v.x); acc[1] += bfhi(v.x); acc[2] += bflo(v.y); acc[3] += bfhi(v.y); acc[4] += bflo(v.z); acc[5] += bfhi(v.z); acc[6] += bflo(v.w); acc[7] += bfhi(v.w); }
        *(LAS f32x4*)(red + row * 64 + ch * 8) = (f32x4){acc[0], acc[1], acc[2], acc[3]};
        *(LAS f32x4*)(red + row * 64 + ch * 8 + 4) = (f32x4){acc[4], acc[5], acc[6], acc[7]};
        __syncthreads();
        if (tid < 64) { float s = 0.f;
#pragma unroll 8
            for (int r = 0; r < 64; ++r) s += red[r * 64 + tid];
            kmean[(size_t)item * 64 + tid] = s * (1.0f / 256.0f); }
        __syncthreads();
    }
}

constexpr int AT_STG = 18688, AT_KPL = 1040, AT_VPL = 4160, AT_VOF = 8320, AT_KXO = 16640;
constexpr int AT_SEL = 3 * AT_STG, AT_KM = AT_SEL + 1024, AT_WL = AT_KM + 4096, AT_OST = AT_WL + 1024, AT_CK = AT_OST + 32768;
typedef short v4i16_t __attribute__((ext_vector_type(4)));
__device__ __forceinline__ s16x4 vtr(const LAS unsigned char* p) { return __builtin_bit_cast(s16x4, __builtin_amdgcn_ds_read_tr16_b64_v4i16((LAS v4i16_t*)p)); }

__device__ __forceinline__ void s_tile(f32x16& c0, f32x16& c1, const LAS unsigned char* Kb, const bf16x8 (&qr)[4]) {
#pragma unroll
    for (int d0 = 0; d0 < 4; ++d0) {
        const bf16x8 b0 = *(const LAS bf16x8*)(Kb + d0 * 2048), b1 = *(const LAS bf16x8*)(Kb + d0 * 2048 + 512);
        c0 = __builtin_amdgcn_mfma_f32_32x32x16_bf16(b0, qr[d0], c0, 0, 0, 0);
        c1 = __builtin_amdgcn_mfma_f32_32x32x16_bf16(b1, qr[d0], c1, 0, 0, 0);
    }
}
__device__ __forceinline__ void fox_init(f32x16& c0, f32x16& c1, const LAS float* ck, float cq2, int hi) {
#pragma unroll
    for (int g = 0; g < 4; ++g) { const f32x4 a = *(const LAS f32x4*)(ck + 8 * g + 4 * hi), bb = *(const LAS f32x4*)(ck + 32 + 8 * g + 4 * hi);
#pragma unroll
        for (int e = 0; e < 4; ++e) { c0[4 * g + e] = cq2 - a[e]; c1[4 * g + e] = cq2 - bb[e]; } }
}
__device__ __forceinline__ void causal_mask(f32x16& c0, f32x16& c1, int jb, int qrel, int hi) {
    const int kb = 64 * jb + 4 * hi;
#pragma unroll
    for (int r = 0; r < 16; ++r) { const int kv = kb + (r & 3) + 8 * (r >> 2); if (kv > qrel) c0[r] = -INFINITY; if (kv + 32 > qrel) c1[r] = -INFINITY; }
}
__device__ __forceinline__ float exp_tile(f32x16& c0, f32x16& c1, u32x4 (&pw)[4]) {
    float ps = 0.f;
#pragma unroll
    for (int r = 0; r < 16; ++r) { c0[r] = __builtin_amdgcn_exp2f(c0[r]); c1[r] = __builtin_amdgcn_exp2f(c1[r]); ps += c0[r] + c1[r]; }
#pragma unroll
    for (int s = 0; s < 2; ++s) {
        pw[s] = (u32x4){cvtpk(c0[8 * s], c0[8 * s + 1]), cvtpk(c0[8 * s + 2], c0[8 * s + 3]), cvtpk(c0[8 * s + 4], c0[8 * s + 5]), cvtpk(c0[8 * s + 6], c0[8 * s + 7])};
        pw[2 + s] = (u32x4){cvtpk(c1[8 * s], c1[8 * s + 1]), cvtpk(c1[8 * s + 2], c1[8 * s + 3]), cvtpk(c1[8 * s + 4], c1[8 * s + 5]), cvtpk(c1[8 * s + 6], c1[8 * s + 7])};
    }
    return ps;
}
__device__ __forceinline__ void pv_tile(f32x16& o0, f32x16& o1, const u32x4 (&pw)[4], const LAS unsigned char* vb) {
#pragma unroll
    for (int ks = 0; ks < 4; ++ks) {
        const bf16x8 pa = __builtin_bit_cast(bf16x8, pw[ks]);
        { const s16x4 lo = vtr(vb + ks * 1024), hh = vtr(vb + ks * 1024 + 512);
          const bf16x8 vf = {lo[0], lo[1], lo[2], lo[3], hh[0], hh[1], hh[2], hh[3]};
          o0 = __builtin_amdgcn_mfma_f32_32x32x16_bf16(pa, vf, o0, 0, 0, 0); }
        { const s16x4 lo = vtr(vb + 4096 + ks * 1024), hh = vtr(vb + 4096 + ks * 1024 + 512);
          const bf16x8 vf = {lo[0], lo[1], lo[2], lo[3], hh[0], hh[1], hh[2], hh[3]};
          o1 = __builtin_amdgcn_mfma_f32_32x32x16_bf16(pa, vf, o1, 0, 0, 0); }
    }
}

template <bool FOX, int VAR = 0>
__device__ __forceinline__ void attn_unit(LAS unsigned char* lds, int b, int h, int qb, const bf16* Q, const bf16* K, const bf16* V, const float* cum2, const float* kmean,
                                          const bf16* sg, bf16* mix, float ref2, int wave_s,
                                          bf16x8 (&qr)[4], u32x4& pk0, u32x4& pv0, u32x4& pk1, u32x4& pv1, int nbh, int nqb) {
    int lane_o; asm volatile("v_mbcnt_lo_u32_b32 %0, -1, 0\n\tv_mbcnt_hi_u32_b32 %0, -1, %0" : "=v"(lane_o));
    const int lane = lane_o & 63, r32 = lane & 31, hi = lane >> 5, wid = wave_s, tid = wave_s * 64 + lane;
    const int bh = b * 8 + h;
    const bf16* Qh = Q + (size_t)bh * SEQ * 64; const bf16* Kh = K + (size_t)bh * SEQ * 64; const bf16* Vh = V + (size_t)bh * SEQ * 64;
    const int q0 = qb * 256 + wid * 32;
    const int NT = 4 * (qb + 1);
    float cqraw = 0.f; if (FOX) cqraw = cum2[(size_t)bh * SEQ + q0 + r32];
    f32x4 kma[4][2], kmb[4][2];
    if (!FOX) { const float* kmp0 = kmean + ((size_t)bh * 16 + r32) * 64 + hi * 8; const bool kvalid = (r32 < qb);
#pragma unroll
        for (int d0 = 0; d0 < 4; ++d0) { kma[d0][0] = kma[d0][1] = kmb[d0][0] = kmb[d0][1] = (f32x4){0.f, 0.f, 0.f, 0.f};
            if (kvalid) { kma[d0][0] = *(const f32x4*)(kmp0 + d0 * 16); kma[d0][1] = *(const f32x4*)(kmp0 + d0 * 16 + 4); kmb[d0][0] = *(const f32x4*)(kmp0 + 65536 + d0 * 16); kmb[d0][1] = *(const f32x4*)(kmp0 + 65536 + d0 * 16 + 4); } } }
    const int qrel4 = 32 * wid + r32 - 4 * hi;
    const int lrow = tid >> 3, lch = tid & 7;
    const bf16* kg = Kh + (size_t)lrow * 64 + lch * 8; const bf16* vg = Vh + (size_t)lrow * 64 + lch * 8;
    const int koff = lch * AT_KPL + lrow * 16, voff = AT_VOF + (lch >> 2) * AT_VPL + lrow * 64 + (lch & 3) * 16;
    const int vlane = AT_VOF + ((lane >> 4) & 1) * 32 + (lane & 3) * 8 + (4 * hi + ((lane & 15) >> 2)) * 64;
    const int klane = hi * AT_KPL + r32 * 16;
    const bf16* kxg = (const bf16*)((const unsigned char*)cum2 - WS_CUM + WS_KX) + ((size_t)bh * SEQ + lane) * 8;
    u32x4 krw, vrw, kxw = {0u, 0u, 0u, 0u};
    if (FOX) { krw = *(const u32x4*)(kg + 2 * 4096); vrw = *(const u32x4*)(vg + 2 * 4096); if (wid == 0) kxw = *(const u32x4*)(kxg + 2 * 512); }
    {   const u32x4 k0 = pk0, v0 = pv0, k1 = pk1, v1 = pv1;
        if (FOX) { f32x4 c0_ = {0.f, 0.f, 0.f, 0.f}, c1_ = c0_; const int nck = 64 * (qb + 1);
            if (tid < nck) c0_ = *(const f32x4*)(cum2 + (size_t)bh * SEQ + tid * 4);
            if (tid + NTHREADS < nck) c1_ = *(const f32x4*)(cum2 + (size_t)bh * SEQ + (tid + NTHREADS) * 4);
            if (tid < nck) *(LAS f32x4*)(lds + AT_CK + tid * 16) = c0_;
            if (tid + NTHREADS < nck) *(LAS f32x4*)(lds + AT_CK + (tid + NTHREADS) * 16) = c1_; }
        *(LAS u32x4*)(lds + koff) = k0; *(LAS u32x4*)(lds + voff) = v0; *(LAS u32x4*)(lds + AT_STG + koff) = k1; *(LAS u32x4*)(lds + AT_STG + voff) = v1;
        if (FOX) { if (wid == 0) { const u32x4 x0 = *(const u32x4*)(kxg), x1 = *(const u32x4*)(kxg + 512); *(LAS u32x4*)(lds + AT_KXO + lane * 16) = x0; *(LAS u32x4*)(lds + AT_STG + AT_KXO + lane * 16) = x1; }
            if (tid >= 64 && tid < 256) *(LAS u32x4*)(lds + ((tid >> 6) - 1) * AT_STG + AT_KXO + 1024 + (tid & 63) * 16) = (u32x4){0u, 0u, 0u, 0u}; } }
    unsigned sel = 0u;
    if (!FOX) {
        const int own = qb;
        f32x16 gacc;
#pragma unroll
        for (int r = 0; r < 16; ++r) gacc[r] = 0.f;
#pragma unroll
        for (int d0 = 0; d0 < 4; ++d0) {
            const float km[8] = {(kma[d0][0].x + kmb[d0][0].x) * (1.0f / 256.0f), (kma[d0][0].y + kmb[d0][0].y) * (1.0f / 256.0f), (kma[d0][0].z + kmb[d0][0].z) * (1.0f / 256.0f), (kma[d0][0].w + kmb[d0][0].w) * (1.0f / 256.0f),
                                 (kma[d0][1].x + kmb[d0][1].x) * (1.0f / 256.0f), (kma[d0][1].y + kmb[d0][1].y) * (1.0f / 256.0f), (kma[d0][1].z + kmb[d0][1].z) * (1.0f / 256.0f), (kma[d0][1].w + kmb[d0][1].w) * (1.0f / 256.0f)};
            u32x4 hw, lw;
#pragma unroll
            for (int j = 0; j < 4; ++j) { const unsigned h_ = cvtpk(km[2 * j], km[2 * j + 1]); hw[j] = h_; lw[j] = cvtpk(km[2 * j] - bflo(h_), km[2 * j + 1] - bfhi(h_)); }
            gacc = __builtin_amdgcn_mfma_f32_32x32x16_bf16(__builtin_bit_cast(bf16x8, hw), qr[d0], gacc, 0, 0, 0);
            gacc = __builtin_amdgcn_mfma_f32_32x32x16_bf16(__builtin_bit_cast(bf16x8, lw), qr[d0], gacc, 0, 0, 0);
        }
        float g[16];
#pragma unroll
        for (int r = 0; r < 8; ++r) { const auto rr_ = __builtin_amdgcn_permlane32_swap(__float_as_uint(gacc[r]), __float_as_uint(gacc[r]), false, false);
            const int blk_ = (r & 3) + 8 * (r >> 2); g[blk_] = __uint_as_float(rr_[0]); g[blk_ + 4] = __uint_as_float(rr_[1]); }
#pragma unroll
        for (int n = 0; n < 15; ++n) g[n] = (n < own) ? g[n] : -INFINITY;
        unsigned mask = 0u;
#pragma unroll
        for (int n = 0; n < 15; ++n) {
            int rank = 0;
#pragma unroll
            for (int m = 0; m < 15; ++m) { if (m < n) rank += (g[m] >= g[n]) ? 1 : 0; else if (m > n) rank += (g[m] > g[n]) ? 1 : 0; }
            if (rank < 3) mask |= 1u << n;
        }
        sel = mask & ((1u << own) - 1u);
        krw = *(const u32x4*)(kg + 2 * 4096); vrw = *(const u32x4*)(vg + 2 * 4096);
    }
    __syncthreads();
    float cq2 = 0.f;
    bf16x8 qx = {0, 0, 0, 0, 0, 0, 0, 0};
    if (FOX) { cq2 = cqraw - ref2;
        const unsigned h_ = cvtpk(cq2, 0.f) & 0xffffu; const float r1_ = cq2 - __uint_as_float(h_ << 16);
        const unsigned m_ = cvtpk(r1_, 0.f) & 0xffffu; const float r2_ = r1_ - __uint_as_float(m_ << 16);
        const unsigned l_ = cvtpk(r2_, 0.f) & 0xffffu;
        const u32x4 w_ = (hi == 0) ? (u32x4){0x3F803F80u, 0x3F80u | (h_ << 16), m_ | (l_ << 16), 0u} : (u32x4){0u, 0u, 0u, 0u};
        qx = __builtin_bit_cast(bf16x8, w_); }
    f32x16 o0, o1;
#pragma unroll
    for (int r = 0; r < 16; ++r) { o0[r] = 0.f; o1[r] = 0.f; }
    float lsum = 0.f;
#define AT_INIT(N0, N1, TILE) do { const int tile_ = (TILE); \
        if (FOX) { const LAS float* ck_ = (const LAS float*)(lds + AT_CK) + tile_ * 64; \
            _Pragma("unroll") for (int g_ = 0; g_ < 4; ++g_) { const f32x4 a_ = *(const LAS f32x4*)(ck_ + 8 * g_ + 4 * hi), b_ = *(const LAS f32x4*)(ck_ + 32 + 8 * g_ + 4 * hi); \
                _Pragma("unroll") for (int e_ = 0; e_ < 4; ++e_) { N0[4 * g_ + e_] = cq2 - a_[e_]; N1[4 * g_ + e_] = cq2 - b_[e_]; } } } \
        else { _Pragma("unroll") for (int r_ = 0; r_ < 16; ++r_) { N0[r_] = 0.f; N1[r_] = 0.f; } } \
        if (tile_ >= NT - 4) { int q4_ = qrel4; asm volatile("" : "+v"(q4_)); const float thr_ = (float)(q4_ - 64 * (tile_ - (NT - 4)));     \
            _Pragma("unroll") for (int r_ = 0; r_ < 16; ++r_) { const float c_ = (float)((r_ & 3) + 8 * (r_ >> 2)); N0[r_] = fminf(N0[r_], (thr_ - c_) * 1e30f); N1[r_] = fminf(N1[r_], (thr_ - (c_ + 32.0f)) * 1e30f); } } } while (0)
#define AT_KF(KFV, STAGE) do { const LAS unsigned char* kb_ = lds + (STAGE) + klane; \
        _Pragma("unroll") for (int d_ = 0; d_ < 4; ++d_) { KFV[2 * d_] = *(const LAS bf16x8*)(kb_ + d_ * 2 * AT_KPL); KFV[2 * d_ + 1] = *(const LAS bf16x8*)(kb_ + d_ * 2 * AT_KPL + 512); } } while (0)
#define AT_KFH(KFV, STAGE, H) do { int ka_ = (STAGE) + klane + (H) * 4 * AT_KPL; asm volatile("" : "+v"(ka_)); const LAS unsigned char* kb_ = lds + ka_; \
        _Pragma("unroll") for (int d_ = 0; d_ < 2; ++d_) { KFV[4 * (H) + 2 * d_] = *(const LAS bf16x8*)(kb_ + d_ * 2 * AT_KPL); KFV[4 * (H) + 2 * d_ + 1] = *(const LAS bf16x8*)(kb_ + d_ * 2 * AT_KPL + 512); } } while (0)
#define AT_EXP4(P, R0, W, J) do { P[R0] = __builtin_amdgcn_exp2f(P[R0]); P[R0 + 1] = __builtin_amdgcn_exp2f(P[R0 + 1]); P[R0 + 2] = __builtin_amdgcn_exp2f(P[R0 + 2]); P[R0 + 3] = __builtin_amdgcn_exp2f(P[R0 + 3]); \
        ps_ += (P[R0] + P[R0 + 1]) + (P[R0 + 2] + P[R0 + 3]); \
        if (FOX) { W[J] = cvtpk(P[R0], P[R0 + 1]); W[J + 1] = cvtpk(P[R0 + 2], P[R0 + 3]); } else { W[J] = cvtpk(P[R0], P[R0 + 1]) & rmu_; W[J + 1] = cvtpk(P[R0 + 2], P[R0 + 3]) & rmu_; } } while (0)
#define AT_VF(VLO, VHI, STAGE, D0) do { int va_ = (STAGE) + vlane + (D0) * AT_VPL; asm volatile("" : "+v"(va_)); const LAS unsigned char* vb_ = lds + va_; \
        _Pragma("unroll") for (int k_ = 0; k_ < 4; ++k_) { VLO[k_] = vtr(vb_ + k_ * 1024); VHI[k_] = vtr(vb_ + k_ * 1024 + 512); } } while (0)
#define AT_VFRAG(VLO, VHI, k) (bf16x8){VLO[k][0], VLO[k][1], VLO[k][2], VLO[k][3], VHI[k][0], VHI[k][1], VHI[k][2], VHI[k][3]}
#define SB() __builtin_amdgcn_sched_barrier(0)
    f32x16 xa0, xa1, xb0, xb1;
    {   bf16x8 kf[8]; AT_INIT(xa0, xa1, 0); AT_KF(kf, 0);
#pragma unroll
        for (int d0 = 0; d0 < 4; ++d0) { xa0 = __builtin_amdgcn_mfma_f32_32x32x16_bf16(kf[2 * d0], qr[d0], xa0, 0, 0, 0); xa1 = __builtin_amdgcn_mfma_f32_32x32x16_bf16(kf[2 * d0 + 1], qr[d0], xa1, 0, 0, 0); } }
    int s_cur = 0, s_nx1 = AT_STG, s_nx2 = 2 * AT_STG;
    u32x4 kra = krw, vra = vrw, kxa = kxw;
#define MFA(D, A, B) asm volatile("s_nop 1\n\tv_mfma_f32_32x32x16_bf16 %0, %1, %2, %0" : "+v"(D) : "v"(A), "v"(B))
#define MFN(D, A, B) asm volatile("v_mfma_f32_32x32x16_bf16 %0, %1, %2, %0" : "+v"(D) : "v"(A), "v"(B))
#define MFZ(D, A, B) asm volatile("v_mfma_f32_32x32x16_bf16 %0, %1, %2, 0" : "=&v"(D) : "v"(A), "v"(B))
#define AT_PINP(P, R0) asm volatile("" : "+v"(P[R0]), "+v"(P[R0 + 1]), "+v"(P[R0 + 2]), "+v"(P[R0 + 3]))
#define AT_PINW(W, J) asm volatile("" : "+v"(W[J]), "+v"(W[J + 1]))
#define AT_G(P, R0, W, J) do { AT_PINP(P, R0); AT_EXP4(P, R0, W, J); AT_PINW(W, J); } while (0)
#define AT_STEP(FAST, P0, P1, N0, N1, KL, VL, XL, KW, VW, XW, T) do { const int t_s = (T); \
        if (t_s + 3 < NT) { KL = *(const u32x4*)(kg + (size_t)(t_s + 3) * 4096); VL = *(const u32x4*)(vg + (size_t)(t_s + 3) * 4096); \
            if (FOX && wid == 0) XL = *(const u32x4*)(kxg + (size_t)(t_s + 3) * 512); } \
        bf16x8 kf[8], kx0, kx1; s16x4 vlo[4], vhi[4]; u32x4 pw[4]; float ps_ = 0.f; \
        const unsigned rmu_ = (FOX || t_s >= NT - 4 || ((sel >> (t_s >> 2)) & 1u)) ? 0xffffffffu : 0u; \
        if (!(FAST)) AT_INIT(N0, N1, t_s + 1); \
        AT_KFH(kf, s_nx1, 0); \
        if (FOX && (FAST)) { const LAS unsigned char* xb_ = lds + s_nx1 + AT_KXO + hi * 1024 + r32 * 16; kx0 = *(const LAS bf16x8*)(xb_); kx1 = *(const LAS bf16x8*)(xb_ + 512); } \
        SB(); \
        if (FOX && (FAST)) { MFZ(N0, kx0, qx); AT_G(P0, 0, pw[0], 0); MFZ(N1, kx1, qx); AT_G(P0, 4, pw[0], 2); MFN(N0, kf[0], qr[0]); AT_G(P0, 8, pw[1], 0); MFN(N1, kf[1], qr[0]); AT_G(P0, 12, pw[1], 2); } \
        else if (FAST) { MFZ(N0, kf[0], qr[0]); AT_G(P0, 0, pw[0], 0); MFZ(N1, kf[1], qr[0]); AT_G(P0, 4, pw[0], 2); } \
        else { MFA(N0, kf[0], qr[0]); AT_G(P0, 0, pw[0], 0); MFA(N1, kf[1], qr[0]); AT_G(P0, 4, pw[0], 2); } \
        AT_KFH(kf, s_nx1, 1); \
        MFN(N0, kf[2], qr[1]); if (!(FOX && (FAST))) AT_G(P0, 8, pw[1], 0); \
        MFN(N1, kf[3], qr[1]); if (!(FOX && (FAST))) AT_G(P0, 12, pw[1], 2); \
        AT_VF(vlo, vhi, s_cur, 0); \
        MFN(N0, kf[4], qr[2]); AT_G(P1, 0, pw[2], 0); \
        MFN(N1, kf[5], qr[2]); AT_G(P1, 4, pw[2], 2); \
        MFN(N0, kf[6], qr[3]); AT_G(P1, 8, pw[3], 0); \
        MFN(N1, kf[7], qr[3]); AT_G(P1, 12, pw[3], 2); \
        lsum += FOX ? ps_ : (rmu_ ? ps_ : 0.f); \
        {   s16x4 wlo[4], whi[4]; \
            _Pragma("unroll") for (int ks = 0; ks < 4; ++ks) { const bf16x8 pa_ = __builtin_bit_cast(bf16x8, pw[ks]); const bf16x8 vf_ = AT_VFRAG(vlo, vhi, ks); MFA(o0, pa_, vf_); if (ks == 1) { AT_VF(wlo, whi, s_cur, 1); } } \
            if (t_s + 2 < NT) { *(LAS u32x4*)(lds + s_nx2 + koff) = KW; *(LAS u32x4*)(lds + s_nx2 + voff) = VW; if (FOX && wid == 0) *(LAS u32x4*)(lds + s_nx2 + AT_KXO + lane * 16) = XW; } \
            _Pragma("unroll") for (int ks = 0; ks < 4; ++ks) { const bf16x8 pa_ = __builtin_bit_cast(bf16x8, pw[ks]); const bf16x8 vf_ = AT_VFRAG(wlo, whi, ks); MFA(o1, pa_, vf_); } } \
        asm volatile("s_waitcnt lgkmcnt(0)\n\ts_barrier" ::: "memory");     \
        { const int t_ = s_cur; s_cur = s_nx1; s_nx1 = s_nx2; s_nx2 = t_; } } while (0)
    {   const int npair = (NT - 2) / 2, nfast = (NT / 2 - 3 > 0) ? NT / 2 - 3 : 0;
#pragma unroll 1
        for (int tp = 0; tp < nfast; ++tp) {
            AT_STEP(1, xa0, xa1, xb0, xb1, kra, vra, kxa, krw, vrw, kxw, 2 * tp);
            AT_STEP(1, xb0, xb1, xa0, xa1, krw, vrw, kxw, kra, vra, kxa, 2 * tp + 1);
        }
#pragma unroll 1
        for (int tp = nfast; tp < npair; ++tp) {
            AT_STEP(0, xa0, xa1, xb0, xb1, kra, vra, kxa, krw, vrw, kxw, 2 * tp);
            AT_STEP(0, xb0, xb1, xa0, xa1, krw, vrw, kxw, kra, vra, kxa, 2 * tp + 1);
        }
        AT_STEP(0, xa0, xa1, xb0, xb1, kra, vra, kxa, krw, vrw, kxw, NT - 2);
    }
    asm volatile("s_nop 15\n\ts_nop 7" : "+v"(o0), "+v"(o1), "+v"(xb0), "+v"(xb1));
    int le; asm volatile("v_mbcnt_lo_u32_b32 %0, -1, 0\n\tv_mbcnt_hi_u32_b32 %0, -1, %0" : "=v"(le)); le &= 63;
    const int colbase = (FOX ? h : 8 + h) * 64;
    const int rowe = le >> 3, che = le & 7;
    const size_t gi0 = ((size_t)(b * SEQ + q0 + rowe)) * 1024 + colbase + che * 8;
    u32x4 gvv[4];
#pragma unroll
    for (int i = 0; i < 4; ++i) gvv[i] = *(const u32x4*)(sg + gi0 + (size_t)i * 8 * 1024);
    if (nbh >= 0) {
        const bf16* nQ = Q + (size_t)nbh * SEQ * 64 + (size_t)(nqb * 256 + wid * 32 + (le & 31)) * 64 + (le >> 5) * 8;
#pragma unroll
        for (int d0 = 0; d0 < 4; ++d0) qr[d0] = *(const bf16x8*)(nQ + d0 * 16);
        const size_t no = (size_t)nbh * SEQ * 64 + (size_t)((wid * 64 + le) >> 3) * 64 + (le & 7) * 8;
        pk0 = *(const u32x4*)(K + no); pv0 = *(const u32x4*)(V + no); pk1 = *(const u32x4*)(K + no + 4096); pv1 = *(const u32x4*)(V + no + 4096);
    } else { pk0 = (u32x4){0u, 0u, 0u, 0u}; pv0 = pk0; pk1 = pk0; pv1 = pk0; }
    {
        u32x4 pw[4]; s16x4 vlo[4], vhi[4], wlo[4], whi[4]; float ps_ = 0.f; const unsigned rmu_ = 0xffffffffu;
        AT_VF(vlo, vhi, s_cur, 0); AT_VF(wlo, whi, s_cur, 1);
        AT_EXP4(xb0, 0, pw[0], 0); AT_EXP4(xb0, 4, pw[0], 2); AT_EXP4(xb0, 8, pw[1], 0); AT_EXP4(xb0, 12, pw[1], 2);
        AT_EXP4(xb1, 0, pw[2], 0); AT_EXP4(xb1, 4, pw[2], 2); AT_EXP4(xb1, 8, pw[3], 0); AT_EXP4(xb1, 12, pw[3], 2);
        lsum += ps_;
#pragma unroll
        for (int ks = 0; ks < 4; ++ks) { o0 = __builtin_amdgcn_mfma_f32_32x32x16_bf16(__builtin_bit_cast(bf16x8, pw[ks]), AT_VFRAG(vlo, vhi, ks), o0, 0, 0, 0);
            o1 = __builtin_amdgcn_mfma_f32_32x32x16_bf16(__builtin_bit_cast(bf16x8, pw[ks]), AT_VFRAG(wlo, whi, ks), o1, 0, 0, 0); }
    }
#undef AT_STEP
#undef AT_G
#undef MFA
#undef MFZ
#undef MFN
#undef AT_PINP
#undef AT_PINW
#undef AT_INIT
#undef AT_KF
#undef AT_EXP4
#undef AT_VF
#undef AT_VFRAG
#undef SB
    { auto rr_ = __builtin_amdgcn_permlane32_swap(__float_as_uint(lsum), __float_as_uint(lsum), false, false); lsum = __uint_as_float(rr_[0]) + __uint_as_float(rr_[1]); }
    {   const int r32e = le & 31, hie = le >> 5;
        LAS float* wl = (LAS float*)(lds + AT_WL) + wid * 32;
        if (hie == 0) wl[r32e] = lsum;
        LAS bf16* stg = (LAS bf16*)(lds + AT_OST) + wid * 2048;
        {   const LAS float* wlp = wl + 4 * hie; LAS bf16* sp = stg + (4 * hie) * 64 + r32e;
#pragma unroll
            for (int r = 0; r < 16; ++r) { const int oc = (r & 3) + 8 * (r >> 2); const float rl = __builtin_amdgcn_rcpf(wlp[oc]);
                sp[oc * 64] = (bf16)(cvtpk(o0[r] * rl, 0.f) & 0xffffu); sp[oc * 64 + 32] = (bf16)(cvtpk(o1[r] * rl, 0.f) & 0xffffu); } }
        const LAS bf16* sr = stg + rowe * 64 + che * 8;
#pragma unroll
        for (int i = 0; i < 4; ++i) {
            const u32x4 ov = *(const LAS u32x4*)(sr + i * 8 * 64);
            const size_t gi = gi0 + (size_t)i * 8 * 1024;
            const u32x4 gv = gvv[i];
            u32x4 res;
            res.x = cvtpk(bflo(ov.x) * bflo(gv.x), bfhi(ov.x) * bfhi(gv.x)); res.y = cvtpk(bflo(ov.y) * bflo(gv.y), bfhi(ov.y) * bfhi(gv.y));
            res.z = cvtpk(bflo(ov.z) * bflo(gv.z), bfhi(ov.z) * bfhi(gv.z)); res.w = cvtpk(bflo(ov.w) * bflo(gv.w), bfhi(ov.w) * bfhi(gv.w));
            *(u32x4*)(mix + gi) = res; } }
    __syncthreads();
}

__device__ __forceinline__ float gain_bound(const float* gq, const float* gk) {
    float mq = 0.f, mk = 0.f;
    for (int i = 0; i < 64; ++i) { mq = fmaxf(mq, fabsf(gq[i])); mk = fmaxf(mk, fabsf(gk[i])); }
    return 8.0f * mq * mk * 1.4426950408889634f * 1.02f + 0.25f;
}

#define AT_DECODE(I, BH, QB) do { const int w0_ = (I) & 255, w_ = ((w0_ & 7) << 5) | (w0_ >> 3), k_ = ((I) >> 8) & 3, sub_ = w_ & 3; BH = w_ >> 2; \
        QB = (k_ == 0) ? 15 - sub_ : (k_ == 1) ? 8 + sub_ : (k_ == 2) ? 7 - sub_ : sub_; } while (0)
#define AT_FIRST(QP, KP, VP) bf16x8 qr[4]; u32x4 pk0 = {0u, 0u, 0u, 0u}, pv0 = pk0, pk1 = pk0, pv1 = pk0; \
        if ((int)blockIdx.x < 1024) { int fbh_, fqb_; AT_DECODE((int)blockIdx.x, fbh_, fqb_); const int ln_ = lane_id(); \
            const bf16* fq_ = (QP) + (size_t)fbh_ * SEQ * 64 + (size_t)(fqb_ * 256 + wave_s * 32 + (ln_ & 31)) * 64 + (ln_ >> 5) * 8; \
            _Pragma("unroll") for (int d0 = 0; d0 < 4; ++d0) qr[d0] = *(const bf16x8*)(fq_ + d0 * 16); \
            const size_t fo_ = (size_t)fbh_ * SEQ * 64 + (size_t)((wave_s * 64 + ln_) >> 3) * 64 + (ln_ & 7) * 8; \
            pk0 = *(const u32x4*)((KP) + fo_); pv0 = *(const u32x4*)((VP) + fo_); pk1 = *(const u32x4*)((KP) + fo_ + 4096); pv1 = *(const u32x4*)((VP) + fo_ + 4096); } \
        else { _Pragma("unroll") for (int d0 = 0; d0 < 4; ++d0) qr[d0] = (bf16x8){0, 0, 0, 0, 0, 0, 0, 0}; }
template <int VAR>
__device__ __forceinline__ void attn_phase(const Args& a, LAS unsigned char* lds, int wave_s, size_t mix_off) {
    unsigned char* ws = a.ws;
    const bf16* qkv = (const bf16*)(ws + WS_QKV); const size_t TS = (size_t)16 << 20;
    const float* cum2 = (const float*)(ws + WS_CUM); const float* kmean = (const float*)(ws + WS_KMP);
    const bf16* sg = (const bf16*)(ws + WS_SG); bf16* mix = (bf16*)(ws + mix_off);
    {   const float ref_f = gain_bound(a.in[4], a.in[5]);
        AT_FIRST(qkv, qkv + TS, qkv + 2 * TS);
#pragma unroll 1
        for (int i = blockIdx.x; i < 1024; i += gridDim.x) {
            int bh, qb, nbh = -1, nqb = 0; AT_DECODE(i, bh, qb); if (i + (int)gridDim.x < 1024) AT_DECODE(i + (int)gridDim.x, nbh, nqb);
            attn_unit<true, VAR>(lds, bh >> 3, bh & 7, qb, qkv, qkv + TS, qkv + 2 * TS, cum2, kmean, sg, mix, ref_f, wave_s, qr, pk0, pv0, pk1, pv1, nbh, nqb);
        } }
    {   const float ref_m = gain_bound(a.in[6], a.in[7]);
        AT_FIRST(qkv + 3 * TS, qkv + 4 * TS, qkv + 5 * TS);
#pragma unroll 1
        for (int i = blockIdx.x; i < 1024; i += gridDim.x) {
            int bh, qb, nbh = -1, nqb = 0; AT_DECODE(i, bh, qb); if (i + (int)gridDim.x < 1024) AT_DECODE(i + (int)gridDim.x, nbh, nqb);
            attn_unit<false, VAR>(lds, bh >> 3, bh & 7, qb, qkv + 3 * TS, qkv + 4 * TS, qkv + 5 * TS, cum2, kmean, sg, mix, ref_m, wave_s, qr, pk0, pv0, pk1, pv1, nbh, nqb);
        } }
}

__device__ __forceinline__ void conv_phase(const Args& a, LAS unsigned char* lds, int wave_s) {
    const int lane = lane_id(), wid = wave_s, tid = wave_s * 64 + lane;
    unsigned char* ws = a.ws;
    const bf16* U = (const bf16*)(ws + WS_U); const bf16* SZ = (const bf16*)(ws + WS_SZ); bf16* A2 = (bf16*)(ws + WS_A2);
    const float* cw = a.in[11]; const float* cb = a.in[12]; const float* lg = a.in[13]; const float* lb = a.in[14];
    const int c0 = 2 * tid;
    float w0[31], w1[31];
#pragma unroll
    for (int j = 0; j < 31; ++j) { const f32x2 wv = *(const f32x2*)(cw + j * 1024 + c0); w0[j] = wv.x; w1[j] = wv.y; }
    const f32x2 bias = *(const f32x2*)(cb + c0), gam = *(const f32x2*)(lg + c0), bet = *(const f32x2*)(lb + c0);
    LAS float* red = (LAS float*)(lds + 62 * 2048);
    u32x4 pre[4];
#define CV_LOAD1(DST, ITEM, K) do { const int m0_ = (ITEM) * 32, t0_ = m0_ & 4095; const int idx_ = tid + (K) * NTHREADS, rr_ = idx_ >> 7, ch_ = idx_ & 127; DST = (u32x4){0u, 0u, 0u, 0u}; \
        if (idx_ < 62 * 128 && t0_ - 30 + rr_ >= 0) DST = *(const u32x4*)(U + (size_t)(m0_ - 30 + rr_) * 1024 + ch_ * 8); } while (0)
    const int vcu = ((int)gridDim.x % 8 == 0) ? ((int)blockIdx.x % 8) * ((int)gridDim.x / 8) + (int)blockIdx.x / 8 : (int)blockIdx.x;
    if (vcu < M_TOK / 32) {
#pragma unroll
        for (int k = 0; k < 4; ++k) CV_LOAD1(pre[k], vcu, k); }
    for (int item = vcu; item < M_TOK / 32; item += gridDim.x) {
        const int m0 = item * 32;
        {   u32x4 late[12];
#pragma unroll
            for (int k = 0; k < 12; ++k) CV_LOAD1(late[k], item, 4 + k);
#pragma unroll
            for (int k = 0; k < 4; ++k) { const int idx = tid + k * NTHREADS, rr = idx >> 7, ch = idx & 127; *(LAS u32x4*)(lds + rr * 2048 + ch * 16) = pre[k]; }
#pragma unroll
            for (int k = 4; k < 16; ++k) { const int idx = tid + k * NTHREADS, rr = idx >> 7, ch = idx & 127; if (idx < 62 * 128) *(LAS u32x4*)(lds + rr * 2048 + ch * 16) = late[k - 4]; } }
        __syncthreads();
        if (item + (int)gridDim.x < M_TOK / 32) {
#pragma unroll
            for (int k = 0; k < 4; ++k) CV_LOAD1(pre[k], item + (int)gridDim.x, k); }
#pragma unroll 1
        for (int half = 0; half < 2; ++half) {
            const LAS unsigned char* ub = lds + half * 16 * 2048 + tid * 4;
            float y0[16], y1[16];
#pragma unroll
            for (int k = 0; k < 16; ++k) { y0[k] = bias.x; y1[k] = bias.y; }
#pragma unroll
            for (int rr = 0; rr < 46; ++rr) {
                const unsigned uu = *(const LAS unsigned*)(ub + rr * 2048);
                const float ua = bflo(uu), ub_ = bfhi(uu);
#pragma unroll
                for (int tok = 0; tok < 16; ++tok) { if (rr - tok >= 0 && rr - tok <= 30) { y0[tok] += w0[rr - tok] * ua; y1[tok] += w1[rr - tok] * ub_; } }
            }
            unsigned zz[16];
#pragma unroll
            for (int tok = 0; tok < 16; ++tok) zz[tok] = *(const unsigned*)(SZ + (size_t)(m0 + half * 16 + tok) * 1024 + c0);
            float k1 = 0.f, k2 = 0.f;
#pragma unroll
            for (int tok = 0; tok < 16; ++tok) { const float s1 = row_sum16(y0[tok] + y1[tok]), s2 = row_sum16(y0[tok] * y0[tok] + y1[tok] * y1[tok]); if ((lane & 15) == tok) { k1 = s1; k2 = s2; } }
            k1 += __shfl_xor(k1, 16); k1 += __shfl_xor(k1, 32); k2 += __shfl_xor(k2, 16); k2 += __shfl_xor(k2, 32);
            if (lane < 16) { red[wid * 16 + lane] = k1; red[128 + wid * 16 + lane] = k2; }
            __syncthreads();
            if (tid < 16) { float s1 = 0.f, s2 = 0.f;
#pragma unroll
                for (int w = 0; w < 8; ++w) { s1 += red[w * 16 + tid]; s2 += red[128 + w * 16 + tid]; }
                const float mean = s1 * (1.0f / 1024.0f); const float var = fmaxf(s2 * (1.0f / 1024.0f) - mean * mean, 0.f);
                red[256 + tid] = mean; red[272 + tid] = 1.0f / sqrtf(var + 1e-5f); }
            __syncthreads();
#pragma unroll
            for (int tok = 0; tok < 16; ++tok) {
                const float mean = red[256 + tok], rstd = red[272 + tok];
                float v0 = (y0[tok] - mean) * rstd * gam.x + bet.x, v1 = (y1[tok] - mean) * rstd * gam.y + bet.y;
                v0 = v0 * __builtin_amdgcn_rcpf(1.f + __expf(-v0)); v1 = v1 * __builtin_amdgcn_rcpf(1.f + __expf(-v1));
                const size_t gi = (size_t)(m0 + half * 16 + tok) * 1024 + c0;
                const unsigned z = zz[tok];
                *(unsigned*)(A2 + gi) = cvtpk(v0 * bflo(z), v1 * bfhi(z));
            }
            __syncthreads();
        }
    }
}

__global__ void __launch_bounds__(NTHREADS, 2) fwd_megakernel(Args a) {
    extern __shared__ __attribute__((aligned(16))) unsigned char lds_raw[];
    LAS unsigned char* lds = (LAS unsigned char*)lds_raw;
    cg::grid_group grid = cg::this_grid();
    unsigned char* ws = a.ws;
    const int lo = a.ph_lo, hi = a.ph_hi;
    volatile LAS unsigned* misc = (volatile LAS unsigned*)(lds + 132096);
    const int wave_s = __builtin_amdgcn_readfirstlane((int)threadIdx.x >> 6);
    if (a.coop == 2) grid.sync();
    if (wave_s == 0 && lane_id() < 2) misc[lane_id()] = 0u;
    __syncthreads();
    XcdBarrier bar; bar.bar = (unsigned*)(ws + WS_BAR); bar.x = 0; bar.st = nullptr; bar.wave = wave_s;
    if (a.coop) bar = xcd_barrier_post((unsigned*)(ws + WS_BAR), misc, wave_s);
#ifndef PH_MASK
#define PH_MASK 0xff
#endif
#define IN(k) (((PH_MASK >> (k)) & 1) && lo <= (k) && (k) < hi)
#define SEAM(k) do { if (a.coop && IN(k) && IN((k) + 1)) xcd_barrier(bar); } while (0)
    if (IN(0)) { for (int rep_ = 0; rep_ < REP_SMALL; ++rep_) { phase_prologue(a, lds, wave_s); __syncthreads(); } }
    SEAM(0);
    if (IN(1)) {
        pg8::Gemm g{(const pg8::bf16_t*)(ws + WS_XB), (const pg8::bf16_t*)(ws + WS_W0T), M_TOK, 4096, 1024}; pg8::StaticOrder S; S.init(M_TOK, 4096, gridDim.x, (int)blockIdx.x);
        pg8::Epi1 E{(const float*)(ws + WS_RSTD0), (pg8::bf16_t*)(ws + WS_QKV), (pg8::bf16_t*)(ws + WS_SG), (const float*)(ws + WS_GAINS), (const float*)(ws + WS_ROPE), (float*)(ws + WS_KMP)};
        _Pragma("unroll 1") for (int rep_ = 0; rep_ < REP_G1; ++rep_) pg8::gemm_phase<pg8::Epi1, pg8::StaticOrder, true, true>(lds, g, S, E, wave_s);
        for (int seq = blockIdx.x; seq < 64; seq += gridDim.x) cumsum_item((const float*)(ws + WS_LOGF), (float*)(ws + WS_CUM), (bf16*)(ws + WS_KX), seq, lds, wave_s);
        if ((int)gridDim.x > 64) { if ((int)blockIdx.x >= 64) late_weights(a, lds, wave_s, ((int)blockIdx.x - 64) * NWAVES + wave_s, ((int)gridDim.x - 64) * NWAVES); }
        else late_weights(a, lds, wave_s, (int)blockIdx.x * NWAVES + wave_s, (int)gridDim.x * NWAVES);
    }
    SEAM(1);
    if (IN(3)) { attn_phase<0>(a, lds, wave_s, WS_MIX);
#if ATT_VAR >= 0
        attn_phase<ATT_VAR>(a, lds, wave_s, WS_END);
#endif
    }
    SEAM(3);
    if (IN(4)) {
        pg8::Gemm g{(const pg8::bf16_t*)(ws + WS_MIX), (const pg8::bf16_t*)(ws + WS_WO0T), M_TOK, 1024, 1024}; pg8::StaticOrder S; S.init(M_TOK, 1024, gridDim.x, (int)blockIdx.x);
        pg8::Epi2 E{a.in[0], a.out, (pg8::bf16_t*)(ws + WS_XB), (float*)(ws + WS_SSQP)};
        _Pragma("unroll 1") for (int rep_ = 0; rep_ < REP_G2; ++rep_) pg8::gemm_phase<pg8::Epi2, pg8::StaticOrder, true, true>(lds, g, S, E, wave_s);
    }
    SEAM(4);
    if (IN(5)) {
        pg8::Gemm g{(const pg8::bf16_t*)(ws + WS_XB), (const pg8::bf16_t*)(ws + WS_W1T), M_TOK, 3072, 1024}; pg8::StaticOrder S; S.init(M_TOK, 3072, gridDim.x, (int)blockIdx.x);
        pg8::Epi3 E{(const float*)(ws + WS_SSQP), (pg8::bf16_t*)(ws + WS_U), (pg8::bf16_t*)(ws + WS_SZ)};
        _Pragma("unroll 1") for (int rep_ = 0; rep_ < REP_G3; ++rep_) pg8::gemm_phase<pg8::Epi3, pg8::StaticOrder, true, true>(lds, g, S, E, wave_s);
    }
    SEAM(5);
    if (IN(6)) { for (int rep_ = 0; rep_ < REP_SMALL; ++rep_) conv_phase(a, lds, wave_s); }
    SEAM(6);
    if (IN(7)) {
        pg8::Gemm g{(const pg8::bf16_t*)(ws + WS_A2), (const pg8::bf16_t*)(ws + WS_WO1T), M_TOK, 1024, 1024}; pg8::StaticOrder S; S.init(M_TOK, 1024, gridDim.x, (int)blockIdx.x);
        pg8::Epi4 E{a.out, (const pg8::bf16_t*)(ws + WS_XB)};
        pg8::gemm_phase<pg8::Epi4, pg8::StaticOrder, true, true>(lds, g, S, E, wave_s);
    }
#undef IN
#undef SEAM
}

#ifndef MK_PER_PHASE
#define MK_PER_PHASE 0
#endif
extern "C" void kernel_launch(void* const* d_in, const int* in_sizes, int n_in, void* d_out, int out_size, void* d_ws, size_t ws_size, hipStream_t stream) {
    static int grid = 0;
    if (grid == 0) {
        if (n_in != 16 || out_size != M_TOK * DM || ws_size < WS_END + 64 * MiB) { fprintf(stderr, "kernel_launch: unexpected shapes (n_in %d out %d ws %zu)\n", n_in, out_size, ws_size); grid = -1; return; }
        int dev = 0, cus = 0, per_cu = 0;
        hipGetDevice(&dev); hipDeviceGetAttribute(&cus, hipDeviceAttributeMultiprocessorCount, dev);
        if (hipFuncSetAttribute((const void*)fwd_megakernel, hipFuncAttributeMaxDynamicSharedMemorySize, LDS_BYTES) != hipSuccess) { fprintf(stderr, "kernel_launch: hipFuncSetAttribute failed\n"); grid = -1; return; }
        if (hipOccupancyMaxActiveBlocksPerMultiprocessor(&per_cu, (const void*)fwd_megakernel, NTHREADS, LDS_BYTES) != hipSuccess || per_cu < 1) { fprintf(stderr, "kernel_launch: occupancy query says %d\n", per_cu); per_cu = 1; }
        (void)hipGetLastError();
        grid = cus * per_cu;
    }
    if (grid < 0) return;
    if (hipMemsetAsync((char*)d_ws + WS_BAR, 0, XCD_BAR_WORDS * 4, stream) != hipSuccess) { fprintf(stderr, "kernel_launch: memset failed\n"); return; }
    Args a{};
    for (int i = 0; i < 16; ++i) a.in[i] = (const float*)d_in[i];
    a.out = (float*)d_out; a.ws = (unsigned char*)d_ws;
#if MK_PER_PHASE
    for (int p = 0; p < 8; ++p) { a.ph_lo = p; a.ph_hi = p + 1; a.coop = 0; hipLaunchKernelGGL(fwd_megakernel, dim3(grid), dim3(NTHREADS), LDS_BYTES, stream, a); }
#else
    a.ph_lo = 0; a.ph_hi = 8; a.coop = 1;
    void* args[] = {&a};
    hipError_t e = hipLaunchCooperativeKernel((const void*)fwd_megakernel, dim3(grid), dim3(NTHREADS), args, LDS_BYTES, stream);
    if (e != hipSuccess) fprintf(stderr, "cooperative launch failed: %s (grid %d)\n", hipGetErrorString(e), grid);
#endif
}
```
